# Optimizing an MI355X kernel written in HIP

```python
import math
import jax, jax.numpy as jnp
from jax import lax
import numpy as np

D_MODEL = 2048
BATCH = 2
SEQ = 4096
DEPTH = 1

ATT_HEADS = 8
ATT_QK_DIM = 64
ATT_V_DIM = 128
ATT_WIDTH = ATT_HEADS * ATT_V_DIM
Q_BLOCK = 128
SG_GROUPS = 8
SG_DIM = 128
SG_WIDTH = SG_GROUPS * SG_DIM
SG_CHUNK = 128
MIX_WIDTH = ATT_WIDTH + SG_WIDTH
Q_OFF = 0
K_OFF = Q_OFF + ATT_HEADS * 2 * ATT_QK_DIM
V_OFF = K_OFF + ATT_HEADS * 2 * ATT_QK_DIM
U_OFF = V_OFF + ATT_WIDTH
G_OFF = U_OFF + SG_WIDTH
IN_WIDTH = G_OFF + SG_WIDTH
REL_BUCKETS = 32
REL_MAX_DIST = 128
N_GROUPS = 4
EXPERTS_PER_GROUP = 8
N_EXPERTS = N_GROUPS * EXPERTS_PER_GROUP
EXPERT_TOPK = 2
D_EXPERT = 256
DN_ALPHA = (2.0 * DEPTH) ** 0.25
DN_BETA = (8.0 * DEPTH) ** -0.25
LN_EPS = 1e-5

kernel_name = "hybrid_diffattn_gmlp_hmoe_deepnorm_encoder"


def _lambda_init(layer):
    return 0.8 - 0.6 * math.exp(-0.3 * layer)


def _layernorm(x, g, b):
    xf = x.astype(jnp.float32)
    mu = jnp.mean(xf, axis=-1, keepdims=True)
    var = jnp.mean(jnp.square(xf - mu), axis=-1, keepdims=True)
    return ((xf - mu) * lax.rsqrt(var + LN_EPS)).astype(x.dtype) * g + b


def _rel_bucket(rel):
    half = REL_BUCKETS // 2
    max_exact = half // 2
    ret = jnp.where(rel > 0, half, 0)
    n = jnp.abs(rel)
    nf = jnp.maximum(n, 1).astype(jnp.float32)
    large = max_exact + (jnp.log(nf / max_exact) / math.log(REL_MAX_DIST / max_exact)
                         * (half - max_exact)).astype(jnp.int32)
    large = jnp.minimum(large, half - 1)
    return ret + jnp.where(n < max_exact, n, large)


def _diff_attention(q, k, v, rel_bias, lam, subln_g, lam_init):
    B, S = q.shape[0], q.shape[1]
    nb = S // Q_BLOCK
    qb = (q * (ATT_QK_DIM ** -0.5)).reshape(B, nb, Q_BLOCK, ATT_HEADS, 2, ATT_QK_DIM)
    qb = qb.transpose(1, 0, 2, 3, 4, 5)
    kpos = jnp.arange(S, dtype=jnp.int32)

    def block(args):
        qblk, start = args
        qpos = start + jnp.arange(Q_BLOCK, dtype=jnp.int32)
        bias = rel_bias[_rel_bucket(kpos[None, :] - qpos[:, None])]
        bias = bias.transpose(2, 0, 1).astype(jnp.float32)
        logits = jnp.einsum('bqhmd,bkhmd->bmhqk', qblk, k).astype(jnp.float32) + bias[None, None]
        probs = jax.nn.softmax(logits, axis=-1)
        attn = probs[:, 0] - lam * probs[:, 1]
        return jnp.einsum('bhqk,bkhd->bqhd', attn.astype(v.dtype), v)

    starts = jnp.arange(nb, dtype=jnp.int32) * Q_BLOCK
    o = lax.map(block, (qb, starts))
    o = o.transpose(1, 0, 2, 3, 4).reshape(B, S, ATT_HEADS, ATT_V_DIM)
    of = o.astype(jnp.float32)
    of = of * lax.rsqrt(jnp.mean(jnp.square(of), axis=-1, keepdims=True) + LN_EPS)
    o = of.astype(v.dtype) * subln_g * (1.0 - lam_init)
    return o.reshape(B, S, ATT_WIDTH)


def _spatial_gating(u, vg, ln_g, ln_b, w_s, b_s):
    B, S = u.shape[0], u.shape[1]
    nc = S // SG_CHUNK
    v = vg.reshape(B, nc, SG_CHUNK, SG_GROUPS, SG_DIM)
    vn = _layernorm(v, ln_g, ln_b)
    mixed = jnp.einsum('gpq,bcqge->bcpge', w_s, vn) + b_s.T[:, :, None]
    return (u.reshape(B, nc, SG_CHUNK, SG_GROUPS, SG_DIM) * mixed).reshape(B, S, SG_WIDTH)


def _hier_moe(x, w_rg, b_rg, w_re, b_re, w_gate, w_up, w_down):
    B, S, D = x.shape
    t = x.reshape(B * S, D)
    g_logits = jnp.einsum('td,dg->tg', t, w_rg).astype(jnp.float32) + b_rg
    g_prob = jax.nn.softmax(g_logits, axis=-1)
    g_idx = jnp.argmax(g_logits, axis=-1)
    g_gate = jnp.take_along_axis(g_prob, g_idx[:, None], axis=-1)
    e_all = jnp.einsum('td,gde->tge', t, w_re).astype(jnp.float32) + b_re
    e_logits = jnp.take_along_axis(e_all, g_idx[:, None, None], axis=1)[:, 0]
    top_v, top_i = lax.top_k(e_logits, EXPERT_TOPK)
    top_w = jax.nn.softmax(top_v, axis=-1) * g_gate
    flat_idx = g_idx[:, None] * EXPERTS_PER_GROUP + top_i
    combine = jnp.sum(jax.nn.one_hot(flat_idx, N_EXPERTS, dtype=jnp.float32) * top_w[..., None], axis=1)
    h = jax.nn.silu(jnp.einsum('td,edf->tef', t, w_gate)) * jnp.einsum('td,edf->tef', t, w_up)
    h = h * combine[:, :, None].astype(t.dtype)
    return jnp.einsum('tef,efd->td', h, w_down).reshape(B, S, D)


def setup_inputs(seed: int = 0) -> dict:
    key = jax.random.key(seed)
    ks = jax.random.split(key, 24)
    f32 = jnp.float32
    D = D_MODEL
    nrm = lambda k, s, sc: jax.random.normal(k, s, f32) * sc
    col_scale = jnp.ones((IN_WIDTH,), f32).at[V_OFF:V_OFF + ATT_WIDTH].set(DN_BETA)
    return {
        "x": jax.random.normal(ks[0], (BATCH, SEQ, D), f32),
        "w_in": nrm(ks[1], (DEPTH, D, IN_WIDTH), D ** -0.5) * col_scale,
        "w_out": nrm(ks[2], (DEPTH, MIX_WIDTH, D), MIX_WIDTH ** -0.5 * DN_BETA),
        "ln1_g": 1.0 + nrm(ks[3], (DEPTH, D), 0.01),
        "ln1_b": nrm(ks[4], (DEPTH, D), 0.01),
        "ln2_g": 1.0 + nrm(ks[5], (DEPTH, D), 0.01),
        "ln2_b": nrm(ks[6], (DEPTH, D), 0.01),
        "rel_bias": nrm(ks[7], (REL_BUCKETS, ATT_HEADS), 0.5),
        "lam_q1": nrm(ks[8], (DEPTH, ATT_QK_DIM), 0.1),
        "lam_k1": nrm(ks[9], (DEPTH, ATT_QK_DIM), 0.1),
        "lam_q2": nrm(ks[10], (DEPTH, ATT_QK_DIM), 0.1),
        "lam_k2": nrm(ks[11], (DEPTH, ATT_QK_DIM), 0.1),
        "subln_g": 1.0 + nrm(ks[12], (DEPTH, ATT_V_DIM), 0.01),
        "sg_ln_g": 1.0 + nrm(ks[13], (DEPTH, SG_GROUPS, SG_DIM), 0.01),
        "sg_ln_b": nrm(ks[14], (DEPTH, SG_GROUPS, SG_DIM), 0.01),
        "sg_w": nrm(ks[15], (DEPTH, SG_GROUPS, SG_CHUNK, SG_CHUNK), SG_CHUNK ** -0.5),
        "sg_b": 1.0 + nrm(ks[16], (DEPTH, SG_GROUPS, SG_CHUNK), 0.1),
        "w_router_group": nrm(ks[17], (DEPTH, D, N_GROUPS), D ** -0.5),
        "b_router_group": nrm(ks[18], (DEPTH, N_GROUPS), 0.01),
        "w_router_expert": nrm(ks[19], (DEPTH, N_GROUPS, D, EXPERTS_PER_GROUP), D ** -0.5),
        "b_router_expert": nrm(ks[20], (DEPTH, N_GROUPS, EXPERTS_PER_GROUP), 0.01),
        "w_exp_gate": nrm(ks[21], (DEPTH, N_EXPERTS, D, D_EXPERT), D ** -0.5),
        "w_exp_up": nrm(ks[22], (DEPTH, N_EXPERTS, D, D_EXPERT), D ** -0.5),
        "w_exp_down": nrm(ks[23], (DEPTH, N_EXPERTS, D_EXPERT, D), D_EXPERT ** -0.5 * DN_BETA),
    }


def reference(x, w_in, w_out, ln1_g, ln1_b, ln2_g, ln2_b, rel_bias, lam_q1, lam_k1, lam_q2, lam_k2,
              subln_g, sg_ln_g, sg_ln_b, sg_w, sg_b, w_router_group, b_router_group,
              w_router_expert, b_router_expert, w_exp_gate, w_exp_up, w_exp_down):
    B, S = x.shape[0], x.shape[1]
    h = x
    for l in range(DEPTH):
        lam_init = _lambda_init(l)
        proj = jnp.einsum('bsd,de->bse', h, w_in[l])
        q = proj[..., Q_OFF:K_OFF].reshape(B, S, ATT_HEADS, 2, ATT_QK_DIM)
        k = proj[..., K_OFF:V_OFF].reshape(B, S, ATT_HEADS, 2, ATT_QK_DIM)
        v = proj[..., V_OFF:U_OFF].reshape(B, S, ATT_HEADS, ATT_V_DIM)
        uv = jax.nn.gelu(proj[..., U_OFF:IN_WIDTH])
        u, vg = uv[..., :SG_WIDTH], uv[..., SG_WIDTH:]
        lam = (jnp.exp(jnp.sum(lam_q1[l].astype(jnp.float32) * lam_k1[l].astype(jnp.float32)))
               - jnp.exp(jnp.sum(lam_q2[l].astype(jnp.float32) * lam_k2[l].astype(jnp.float32)))
               + lam_init)
        a = _diff_attention(q, k, v, rel_bias, lam, subln_g[l], lam_init)
        s = _spatial_gating(u, vg, sg_ln_g[l], sg_ln_b[l], sg_w[l], sg_b[l])
        mix = jnp.einsum('bse,ed->bsd', jnp.concatenate([a, s], axis=-1), w_out[l])
        h = _layernorm(DN_ALPHA * h + mix, ln1_g[l], ln1_b[l])
        ffn = _hier_moe(h, w_router_group[l], b_router_group[l], w_router_expert[l], b_router_expert[l],
                        w_exp_gate[l], w_exp_up[l], w_exp_down[l])
        h = _layernorm(DN_ALPHA * h + ffn, ln2_g[l], ln2_b[l])
    return h
```

```cpp
#include <hip/hip_runtime.h>
#include <cstdio>
#include <cstdint>

#ifndef MK_N_LAUNCHES
#define MK_N_LAUNCHES 1
#endif

#define GAS __attribute__((address_space(1)))
#define LAS __attribute__((address_space(3)))
typedef unsigned short bf16_t;
typedef short bf16x8 __attribute__((ext_vector_type(8)));
typedef short s16x4 __attribute__((ext_vector_type(4)));
typedef float f32x2 __attribute__((ext_vector_type(2)));
typedef float f32x4 __attribute__((ext_vector_type(4)));
typedef float f32x16 __attribute__((ext_vector_type(16)));
typedef unsigned u32x2 __attribute__((ext_vector_type(2)));
typedef unsigned u32x4 __attribute__((ext_vector_type(4)));

constexpr int TOK = 8192, SEQ = 4096, DM = 2048, INW = 5120, NH = 8;
constexpr int NEXP = 32, DEXP = 256, EPG = 8;
constexpr int Q_OFF = 0, K_OFF = 1024, V_OFF = 2048, U_OFF = 3072, G_OFF = 4096;
constexpr float DN_ALPHA = 1.189207115002721f;
constexpr float LN_EPS = 1e-5f;
constexpr float LOG2E = 1.4426950408889634f;
constexpr float QSCALE = 0.125f * LOG2E;
constexpr float SUBLN_MUL = 0.8f;
constexpr float LAM_INIT = 0.2f;

constexpr size_t MiB = 1u << 20;
constexpr size_t WS_CTL = 0, CTL_ZERO_BYTES = 1 * MiB;
constexpr size_t WS_TOKL = 1 * MiB, WS_TOKW = 2 * MiB;
constexpr size_t WS_SGW = 3 * MiB;
constexpr size_t WS_WGU = 4 * MiB;
constexpr size_t WS_WD = 68 * MiB;
constexpr size_t WS_WIN = 100 * MiB;
constexpr size_t WS_WOUT = 120 * MiB;
constexpr size_t WS_XB = 128 * MiB;
constexpr size_t WS_MIX = 160 * MiB;
constexpr size_t WS_P = 192 * MiB;
constexpr size_t WS_H1 = 100 * MiB;
constexpr size_t WS_H1B = 164 * MiB;
constexpr size_t WS_HB = 196 * MiB;
constexpr size_t WS_Y = 208 * MiB;
constexpr size_t WS_O = 208 * MiB;
constexpr size_t WS_END = 272 * MiB;
constexpr int CW_CNT = 1024;
constexpr int CW_BAR = 4096;

constexpr int RING_BYTES = 131072;
constexpr int LDSX_OFF = RING_BYTES;
constexpr int MISC_OFF = RING_BYTES + 8192;
constexpr int LDS_BYTES = 147456;

#define RLX_AGENT __ATOMIC_RELAXED, __HIP_MEMORY_SCOPE_AGENT
#define LDS_WAIT() asm volatile("s_waitcnt lgkmcnt(0)" ::: "memory")
#define VM_WAIT() asm volatile("s_waitcnt vmcnt(0)" ::: "memory")

__device__ __forceinline__ unsigned cvt_pk_bf16(float lo, float hi) { unsigned r; asm volatile("v_cvt_pk_bf16_f32 %0, %1, %2" : "=v"(r) : "v"(lo), "v"(hi)); return r; }
__device__ __forceinline__ float bf2f(unsigned short b) { return __uint_as_float(((unsigned)b) << 16); }
__device__ __forceinline__ float bflo(unsigned w) { return __uint_as_float(w << 16); }
__device__ __forceinline__ float bfhi(unsigned w) { return __uint_as_float(w & 0xffff0000u); }

namespace pg8 {
constexpr int BM = 256, BK = 64, HALF = 128, HTB = HALF * BK * 2, NXCD = 8, WGM = 8;
__host__ __device__ __forceinline__ int lds_byte(int r, int c) { const int st = (r >> 4) * 2 + (c >> 5), rr = r & 15, cc = c & 31, ob = rr * 64 + cc * 2; return st * 1024 + (ob ^ (((ob >> 9) & 1) << 5)); }
__host__ __device__ __forceinline__ void stage_rc(int b, int& R, int& C) { const int st = b / 1024, sb = b % 1024, swz = sb ^ (((sb >> 9) & 1) << 5); R = (st >> 1) * 16 + swz / 64; C = (st & 1) * 32 + (swz % 64) / 2; }
__host__ __device__ __forceinline__ int perm32(int rho) { const int n = rho >> 4, i = rho & 15; return 8 * (i >> 2) + 4 * n + (i & 3); }

struct Unit { int pm, pn; const char* A; const char* B; int aux0, aux1; };

struct SchedDense {
    int nM, nN, nwg, G, c; const char* A; const char* B; size_t ta, tb;
    __device__ __forceinline__ void init(int M, int N, int K, int G_, int c_, const void* A_, const void* B_) { nM = M / BM; nN = N / BM; nwg = nM * nN; G = G_; c = c_; A = (const char*)A_; B = (const char*)B_; ta = (size_t)BM * K * 2; tb = ta; }
    __device__ __forceinline__ bool next(int i, Unit& u) const {
        const long L = (long)i * G + c; if (L >= nwg) return false;
        int wgid = (int)L; { const int q = nwg / NXCD, r = nwg % NXCD, xcd = wgid % NXCD, off = wgid / NXCD; wgid = (xcd < r ? xcd * (q + 1) : r * (q + 1) + (xcd - r) * q) + off; }
        const int nig = WGM * nN, gid = wgid / nig, fm = gid * WGM, gsz = (nM - fm) < WGM ? (nM - fm) : WGM;
        u.pm = fm + ((wgid % nig) % gsz); u.pn = (wgid % nig) / gsz; u.A = A + (size_t)u.pm * ta; u.B = B + (size_t)u.pn * tb; u.aux0 = 0; u.aux1 = 0; return true;
    }
};

template <class Epi, class Sched, bool GATHER>
__device__ __forceinline__ void gemm_phase(LAS unsigned char* lds, const int K, const Sched& S, const Epi& E, const int* gtok  ) {
    const int tid = threadIdx.x, wid = __builtin_amdgcn_readfirstlane(tid >> 6), lane = tid & 63, wr = wid >> 2, wc = wid & 3, fr = lane & 15, fq = lane >> 4;
    const int nt = K / BK;
    unsigned voffA[2][2], voffB[2]; int RA[2], CA[2];
#pragma unroll
    for (int i = 0; i < 2; ++i) { int R, C; stage_rc(tid * 16 + i * 8192, R, C); const int Rb = Epi::PERM ? ((R & ~31) + perm32(R & 31)) : R;
        RA[i] = R; CA[i] = C;
        voffA[0][i] = (unsigned)(R * K + C) * 2u; voffA[1][i] = (unsigned)((R + HALF) * K + C) * 2u; voffB[i] = (unsigned)(Rb * K + C) * 2u; }
    const size_t kstep = (size_t)(BK * 2);
    const size_t hstep = (size_t)HALF * K * 2;
    const unsigned ldsw = (unsigned)wid * 1024u;
    const int aoff = lds_byte(wr * 64 + fr, fq * 8), boff = lds_byte(wc * 32 + fr, fq * 8);
#define PG8_SA(b, h) (((b) * 2 + (h)) * HTB)
#define PG8_SB(b, h) ((4 + (b) * 2 + (h)) * HTB)
#define PG8_STAGE(bufoff, gbase, voff) do { _Pragma("unroll") for (int _i = 0; _i < 2; ++_i) \
        __builtin_amdgcn_global_load_lds((const unsigned*)((const char*)(gbase) + (voff)[_i]), (LAS unsigned*)(lds + (bufoff) + ldsw + _i * 8192), 16, 0, 0); } while (0)
#define PG8_LDA(dst, b, h) do { _Pragma("unroll") for (int m = 0; m < 4; ++m) _Pragma("unroll") for (int k = 0; k < 2; ++k) dst[m][k] = *(const LAS bf16x8*)(lds + PG8_SA(b, h) + aoff + m * 2048 + k * 1024); } while (0)
#define PG8_LDB(dst, b, h) do { _Pragma("unroll") for (int n = 0; n < 2; ++n) _Pragma("unroll") for (int k = 0; k < 2; ++k) dst[n][k] = *(const LAS bf16x8*)(lds + PG8_SB(b, h) + boff + n * 2048 + k * 1024); } while (0)
#define PG8_MMA(ai, bj, At, Bt) do { __builtin_amdgcn_s_setprio(1); _Pragma("unroll") for (int m = 0; m < 4; ++m) _Pragma("unroll") for (int n = 0; n < 2; ++n) _Pragma("unroll") for (int k = 0; k < 2; ++k) \
        acc[ai][bj][m][n] = __builtin_amdgcn_mfma_f32_16x16x32_bf16(Bt[n][k], At[m][k], acc[ai][bj][m][n], 0, 0, 0); __builtin_amdgcn_s_setprio(0); } while (0)
#define PG8_WAIT_V(n) asm volatile("s_waitcnt vmcnt(" #n ")" ::: "memory")
#define PG8_WAIT_L(n) asm volatile("s_waitcnt lgkmcnt(" #n ")" ::: "memory")
#define PG8_BAR __builtin_amdgcn_s_barrier()
#define PG8_SCHED __builtin_amdgcn_sched_barrier(0)
    Unit cur, nxt; int ui = 0;
    if (!S.next(0, cur)) return;
    f32x4 acc[2][2][4][2];
    bf16x8 At[4][2], B0[2][2], B1[2][2];
    for (;;) {
#pragma unroll
        for (int a = 0; a < 2; ++a)
#pragma unroll
            for (int b = 0; b < 2; ++b)
#pragma unroll
                for (int m = 0; m < 4; ++m)
#pragma unroll
                    for (int n = 0; n < 2; ++n) acc[a][b][m][n] = (f32x4){0.f, 0.f, 0.f, 0.f};
        if constexpr (GATHER) {
#pragma unroll
            for (int h = 0; h < 2; ++h)
#pragma unroll
                for (int i = 0; i < 2; ++i) { const int rw = h * HALF + RA[i]; int t = 0; if (rw < cur.aux1) t = gtok[cur.aux0 + rw] & 0xffff; voffA[h][i] = (unsigned)(t * K + CA[i]) * 2u; }
            VM_WAIT();
        }
        const char* cA = cur.A; const char* cB = cur.B;
        PG8_STAGE(PG8_SB(0, 0), cB, voffB); PG8_STAGE(PG8_SB(0, 1), cB + hstep, voffB); PG8_STAGE(PG8_SA(0, 0), cA, voffA[0]); PG8_STAGE(PG8_SA(0, 1), cA, voffA[1]);
        if (wr == 1) PG8_BAR;
        PG8_WAIT_V(2); PG8_BAR;
        PG8_STAGE(PG8_SB(1, 0), cB + kstep, voffB); PG8_STAGE(PG8_SA(1, 0), cA + kstep, voffA[0]); PG8_STAGE(PG8_SB(1, 1), cB + hstep + kstep, voffB);
        PG8_WAIT_V(6); PG8_BAR;
        bool more = false;
        for (;;) {
            const bool has_next = GATHER ? false : S.next(ui + 1, nxt);
            const char* nA = has_next ? nxt.A : cA; const char* nB = has_next ? nxt.B : cB;
#pragma unroll 1
            for (int t = 0; t < nt; t += 2) {
                const bool last = (t == nt - 2);
                const char* a1 = cA + (size_t)(t + 1) * kstep;
                const char* a2 = last ? nA : cA + (size_t)(t + 2) * kstep; const char* b2 = last ? nB : cB + (size_t)(t + 2) * kstep;
                const char* a3 = a2 + kstep; const char* b3 = b2 + kstep;
                PG8_LDB(B0, 0, 0); PG8_LDB(B1, 0, 1); PG8_SCHED; PG8_LDA(At, 0, 0); PG8_STAGE(PG8_SA(1, 1), a1, voffA[1]);
                PG8_WAIT_V(8); PG8_WAIT_L(0); PG8_BAR; PG8_MMA(0, 0, At, B0); PG8_MMA(0, 1, At, B1); PG8_BAR; PG8_SCHED;
                PG8_LDA(At, 0, 1); PG8_STAGE(PG8_SB(0, 0), b2, voffB); PG8_STAGE(PG8_SB(0, 1), b2 + hstep, voffB); PG8_STAGE(PG8_SA(0, 0), a2, voffA[0]);
                PG8_WAIT_V(8); PG8_WAIT_L(0); PG8_BAR; PG8_MMA(1, 0, At, B0); PG8_MMA(1, 1, At, B1); PG8_BAR; PG8_SCHED;
                PG8_LDB(B0, 1, 0); PG8_LDB(B1, 1, 1); PG8_SCHED; PG8_LDA(At, 1, 0); PG8_STAGE(PG8_SA(0, 1), a2, voffA[1]);
                PG8_WAIT_V(8); PG8_WAIT_L(0); PG8_BAR; PG8_MMA(0, 0, At, B0); PG8_MMA(0, 1, At, B1); PG8_BAR; PG8_SCHED;
                PG8_LDA(At, 1, 1); PG8_STAGE(PG8_SB(1, 0), b3, voffB); PG8_STAGE(PG8_SB(1, 1), b3 + hstep, voffB); PG8_STAGE(PG8_SA(1, 0), a3, voffA[0]);
                PG8_WAIT_V(8); PG8_WAIT_L(0); PG8_BAR; PG8_MMA(1, 0, At, B0); PG8_MMA(1, 1, At, B1); PG8_BAR; PG8_SCHED;
            }
            if (wr == 0) PG8_BAR;
            E(acc, cur, wr, wc, fr, fq);
            if (!has_next) { if constexpr (GATHER) { more = S.next(ui + 1, nxt); } break; }
#pragma unroll
            for (int a = 0; a < 2; ++a)
#pragma unroll
                for (int b = 0; b < 2; ++b)
#pragma unroll
                    for (int m = 0; m < 4; ++m)
#pragma unroll
                        for (int n = 0; n < 2; ++n) acc[a][b][m][n] = (f32x4){0.f, 0.f, 0.f, 0.f};
            cur = nxt; cA = nA; cB = nB; ++ui;
            if (wr == 1) PG8_BAR;
        }
        PG8_WAIT_V(0);
        PG8_BAR;
        if (!more) break;
        cur = nxt; ++ui;
    }
#undef PG8_SA
#undef PG8_SB
#undef PG8_STAGE
#undef PG8_LDA
#undef PG8_LDB
#undef PG8_MMA
#undef PG8_WAIT_V
#undef PG8_WAIT_L
#undef PG8_BAR
#undef PG8_SCHED
}
}

#define XB_TMO      128
#define XB_XCNT(j)  (256  + 64 * (j))
#define XB_XSUB(j)  (1280 + 64 * (j))
#define XB_XGEN(j)  (2304 + 64 * (j))
#define XB_TOP      3328
#define XB_TOPGEN   3392
#define XCD_BAR_WORDS 3456
#define XB_SPIN_CAP (1u << 18)
__device__ __forceinline__ unsigned xb_ld(unsigned* p)              { return __hip_atomic_load(p, __ATOMIC_RELAXED, __HIP_MEMORY_SCOPE_AGENT); }
__device__ __forceinline__ unsigned xb_add(unsigned* p, unsigned v) { return __hip_atomic_fetch_add(p, v, __ATOMIC_RELAXED, __HIP_MEMORY_SCOPE_AGENT); }
__device__ __forceinline__ unsigned xb_xcc_id() { return (unsigned)__builtin_amdgcn_s_getreg((3 << 11) | 20) & 0xFu; }
#define XB_SPIN(cond, bar) do { unsigned _sp = 0; while (cond) { __builtin_amdgcn_s_sleep(1); \
    if ((++_sp & 255u) == 0u) { if (xb_ld(&(bar)[XB_TMO])) break; if (_sp > XB_SPIN_CAP) { atomicAdd(&(bar)[XB_TMO], 1u); break; } } } } while (0)
struct XcdBarrier { unsigned* bar; unsigned x; volatile LAS unsigned* st; };
__device__ __forceinline__ XcdBarrier xcd_barrier_post(unsigned* bar, volatile LAS unsigned* st) {
    XcdBarrier b; b.bar = bar; b.x = xb_xcc_id(); b.st = st;
    if (threadIdx.x == 0) (void)xb_add(&bar[XB_XCNT(b.x)], 1u);
    return b;
}
__device__ __forceinline__ void xcd_barrier_complete(unsigned* bar, unsigned x, unsigned& nloc, unsigned& nx) {
    const unsigned G = gridDim.x * gridDim.y * gridDim.z;
    unsigned sum, cnt, mine, sp = 0u;
    for (;;) {
        sum = 0u; cnt = 0u; mine = 0u;
#pragma unroll
        for (unsigned j = 0; j < 16; ++j) { const unsigned c = xb_ld(&bar[XB_XCNT(j)]); sum += c; cnt += (c > 0u) ? 1u : 0u; mine = (j == x) ? c : mine; }
        if (sum == G) break;
        __builtin_amdgcn_s_sleep(1);
        if ((++sp & 255u) == 0u) { if (xb_ld(&bar[XB_TMO])) break; if (sp > XB_SPIN_CAP) { atomicAdd(&bar[XB_TMO], 1u); break; } }
    }
    nloc = mine > 0u ? mine : 1u; nx = cnt > 0u ? cnt : 1u;
}
__device__ __forceinline__ void xcd_barrier(const XcdBarrier& b) {
    asm volatile("s_waitcnt vmcnt(0)" ::: "memory");
    __syncthreads();
    if (threadIdx.x == 0) {
        unsigned* bar = b.bar;
        __builtin_amdgcn_s_waitcnt(0);
        unsigned nloc = b.st[0], nx = b.st[1];
        if (nloc == 0u) { xcd_barrier_complete(bar, b.x, nloc, nx); b.st[0] = nloc; b.st[1] = nx; }
        const unsigned old = xb_add(&bar[XB_XSUB(b.x)], 1u);
        const unsigned gen = old / nloc;
        if (old + 1u == (gen + 1u) * nloc) {
            __builtin_amdgcn_fence(__ATOMIC_RELEASE, "agent");
            asm volatile("s_waitcnt vmcnt(0)" ::: "memory");
            const unsigned og = xb_add(&bar[XB_TOP], 1u);
            const unsigned tg = og / nx;
            if (og + 1u == (tg + 1u) * nx) xb_add(&bar[XB_TOPGEN], 1u);
            else XB_SPIN(xb_ld(&bar[XB_TOPGEN]) == tg, bar);
            __builtin_amdgcn_fence(__ATOMIC_ACQUIRE, "agent");
            xb_add(&bar[XB_XGEN(b.x)], 1u);
            asm volatile("s_waitcnt vmcnt(0)" ::: "memory");
        } else {
            XB_SPIN(xb_ld(&bar[XB_XGEN(b.x)]) == gen, bar);
            __builtin_amdgcn_fence(__ATOMIC_ACQUIRE, "agent");
            asm volatile("s_waitcnt vmcnt(0)" ::: "memory");
        }
    }
    __syncthreads();
}

__device__ __forceinline__ float gelu_tanh(float v) {
    const float t = v * (-2.302208198f + (-0.1029432319f) * v * v);
    const float e = __builtin_amdgcn_exp2f(t);
    return v * __builtin_amdgcn_rcpf(1.0f + e);
}
struct EpiProj {
    static constexpr bool PERM = true;
    bf16_t* O;
    __device__ __forceinline__ void operator()(const f32x4 (&acc)[2][2][4][2], const pg8::Unit& u, int wr, int wc, int fr, int fq) const {
        const int row0 = u.pm * 256 + wr * 64 + fr, col0 = u.pn * 256 + wc * 32 + 8 * fq;
        const int kind = u.pn < 4 ? 0 : (u.pn < 12 ? 1 : 2);
#pragma unroll
        for (int ai = 0; ai < 2; ++ai)
#pragma unroll
            for (int m = 0; m < 4; ++m) { bf16_t* rowp = O + (size_t)(row0 + ai * 128 + m * 16) * INW + col0;
#pragma unroll
                for (int bj = 0; bj < 2; ++bj) { f32x4 v0 = acc[ai][bj][m][0], v1 = acc[ai][bj][m][1];
                    if (kind == 0) { v0 = v0 * QSCALE; v1 = v1 * QSCALE; }
                    else if (kind == 2) {
#pragma unroll
                        for (int j = 0; j < 4; ++j) { v0[j] = gelu_tanh(v0[j]); v1[j] = gelu_tanh(v1[j]); } }
                    u32x4 w; w.x = cvt_pk_bf16(v0[0], v0[1]); w.y = cvt_pk_bf16(v0[2], v0[3]); w.z = cvt_pk_bf16(v1[0], v1[1]); w.w = cvt_pk_bf16(v1[2], v1[3]);
                    *(u32x4*)(rowp + bj * 128) = w; } }
    }
};
struct EpiY {
    static constexpr bool PERM = false;
    const float* X; float* Y;
    __device__ __forceinline__ void operator()(const f32x4 (&acc)[2][2][4][2], const pg8::Unit& u, int wr, int wc, int fr, int fq) const {
        const int row0 = u.pm * 256 + wr * 64 + fr, col0 = u.pn * 256 + wc * 32 + 4 * fq;
#pragma unroll
        for (int ai = 0; ai < 2; ++ai)
#pragma unroll
            for (int m = 0; m < 4; ++m) { const size_t off = (size_t)(row0 + ai * 128 + m * 16) * DM + col0;
#pragma unroll
                for (int bj = 0; bj < 2; ++bj)
#pragma unroll
                    for (int n = 0; n < 2; ++n) { const f32x4 xv = *(const f32x4*)(X + off + bj * 128 + n * 16);
                        *(f32x4*)(Y + off + bj * 128 + n * 16) = xv * DN_ALPHA + acc[ai][bj][m][n]; } }
    }
};
struct EpiGU {
    static constexpr bool PERM = true;
    bf16_t* H; const float* tokw;
    __device__ __forceinline__ void operator()(const f32x4 (&acc)[2][2][4][2], const pg8::Unit& u, int wr, int wc, int fr, int fq) const {
        const int rl0 = wr * 64 + fr, col0 = u.pn * 128 + wc * 32 + 8 * fq;
#pragma unroll
        for (int ai = 0; ai < 2; ++ai)
#pragma unroll
            for (int m = 0; m < 4; ++m) { const int rl = rl0 + ai * 128 + m * 16; const float w = rl < u.aux1 ? tokw[u.aux0 + rl] : 0.f;
                const f32x4 g0 = acc[ai][0][m][0], g1 = acc[ai][0][m][1], u0 = acc[ai][1][m][0], u1 = acc[ai][1][m][1]; f32x4 h0, h1;
#pragma unroll
                for (int j = 0; j < 4; ++j) { h0[j] = g0[j] * __builtin_amdgcn_rcpf(1.0f + __builtin_amdgcn_exp2f(-LOG2E * g0[j])) * u0[j] * w;
                                              h1[j] = g1[j] * __builtin_amdgcn_rcpf(1.0f + __builtin_amdgcn_exp2f(-LOG2E * g1[j])) * u1[j] * w; }
                u32x4 o; o.x = cvt_pk_bf16(h0[0], h0[1]); o.y = cvt_pk_bf16(h0[2], h0[3]); o.z = cvt_pk_bf16(h1[0], h1[1]); o.w = cvt_pk_bf16(h1[2], h1[3]);
                *(u32x4*)(H + (size_t)(u.pm * 256 + rl) * DEXP + col0) = o; }
    }
};
struct EpiDown {
    static constexpr bool PERM = true;
    bf16_t* O; const int* tokl;
    __device__ __forceinline__ void operator()(const f32x4 (&acc)[2][2][4][2], const pg8::Unit& u, int wr, int wc, int fr, int fq) const {
        const int rl0 = wr * 64 + fr, col0 = u.pn * 256 + wc * 32 + 8 * fq;
        const __amdgpu_buffer_rsrc_t rs = __builtin_amdgcn_make_buffer_rsrc(O, 0, 2 * TOK * DM * 2, 0x00020000);
        int ent[2][4];
#pragma unroll
        for (int ai = 0; ai < 2; ++ai)
#pragma unroll
            for (int m = 0; m < 4; ++m) { const int rl = rl0 + ai * 128 + m * 16; ent[ai][m] = rl < u.aux1 ? tokl[u.aux0 + rl] : -1; }
#pragma unroll
        for (int ai = 0; ai < 2; ++ai)
#pragma unroll
            for (int m = 0; m < 4; ++m) { const int e = ent[ai][m];
                if (e >= 0) { const unsigned voff = (unsigned)((((e >> 16) * TOK + (e & 0xffff)) * DM + col0) * 2);
#pragma unroll
                    for (int bj = 0; bj < 2; ++bj) { const f32x4 v0 = acc[ai][bj][m][0], v1 = acc[ai][bj][m][1];
                        u32x4 w; w.x = cvt_pk_bf16(v0[0], v0[1]); w.y = cvt_pk_bf16(v0[2], v0[3]); w.z = cvt_pk_bf16(v1[0], v1[1]); w.w = cvt_pk_bf16(v1[2], v1[3]);
                        __builtin_amdgcn_raw_buffer_store_b128(w, rs, voff + bj * 256, 0, 0); } } }
    }
};
struct SchedMoE {
    const LAS int* tab; int ncol, G, c; const char* A; const char* B; size_t btile;
    bool gather;
    __device__ __forceinline__ bool next(int i, pg8::Unit& u) const {
        const int NT = __builtin_amdgcn_readfirstlane(tab[0]);
        const int L = i * G + c; if (L >= NT * ncol) return false;
        const int t = L / ncol, pn = L % ncol;
        const int e = __builtin_amdgcn_readfirstlane(tab[1 + 4 * t]), lt = __builtin_amdgcn_readfirstlane(tab[2 + 4 * t]), nv = __builtin_amdgcn_readfirstlane(tab[3 + 4 * t]);
        u.pm = t; u.pn = pn; u.aux0 = e * TOK + lt * 256; u.aux1 = nv;
        u.A = gather ? A : A + (size_t)t * 256 * DEXP * 2;
        u.B = B + ((size_t)e * ncol + pn) * btile;
        return true;
    }
};

__device__ __forceinline__ float wave_sum(float v) {
#pragma unroll
    for (int o = 1; o < 64; o <<= 1) v += __shfl_xor(v, o);
    return v;
}
__device__ __forceinline__ void tr_item(const float* W, int ldw, bf16_t* WT, int ldwt, LAS float* scr, int lane) {
#pragma unroll 8
    for (int i = 0; i < 32; ++i) { const int kk = 2 * i + (lane >> 5); scr[kk * 33 + (lane & 31)] = W[(size_t)kk * ldw + (lane & 31)]; }
    LDS_WAIT(); asm volatile("" ::: "memory");
    const int c = lane & 7;
#pragma unroll
    for (int j = 0; j < 4; ++j) { const int n = (lane >> 3) + 8 * j; const LAS float* s = scr + (8 * c) * 33 + n;
        u32x4 o; o.x = cvt_pk_bf16(s[0 * 33], s[1 * 33]); o.y = cvt_pk_bf16(s[2 * 33], s[3 * 33]); o.z = cvt_pk_bf16(s[4 * 33], s[5 * 33]); o.w = cvt_pk_bf16(s[6 * 33], s[7 * 33]);
        *(GAS u32x4*)(WT + (size_t)n * ldwt + 8 * c) = o; }
    LDS_WAIT(); asm volatile("" ::: "memory");
}

namespace att {
constexpr int LDP = INW;
constexpr int SHM_V = 16384, SHM_K = 16384;
constexpr int OFF_WS = 65536, OFF_TBL = 65536 + 2048;
constexpr float THR2 = 8.f * LOG2E;
#define KSWZ(row, colB) ((row) * 256 + ((colB) ^ (((row) & 7) << 4)))
#define SBAR() __builtin_amdgcn_sched_barrier(0)
__device__ __forceinline__ int crow(int r, int hi) { return (r & 3) + 8 * (r >> 2) + 4 * hi; }
__device__ __forceinline__ unsigned cvtpk(float lo, float hi) { unsigned r; asm volatile("v_cvt_pk_bf16_f32 %0, %1, %2" : "=v"(r) : "v"(lo), "v"(hi)); return r; }

__device__ __forceinline__ void partialSM(f32x16& p0, f32x16& p1, float& m_reg, float& mn, float& alpha, int dk, float c_lo, float c_hi, const float* tblp) {
    float c;
    if (dk < -153) c = c_lo; else if (dk > 121) c = c_hi;
    else { c = 0.f; const float* t = tblp + dk;
#pragma unroll
        for (int r = 0; r < 16; ++r) { p0[r] += t[(r & 3) + 8 * (r >> 2)]; p1[r] += t[32 + (r & 3) + 8 * (r >> 2)]; } }
    float pmax = p0[0];
#pragma unroll
    for (int r = 1; r < 16; ++r) pmax = fmaxf(pmax, p0[r]);
#pragma unroll
    for (int r = 0; r < 16; ++r) pmax = fmaxf(pmax, p1[r]);
    { auto rr = __builtin_amdgcn_permlane32_swap(__float_as_uint(pmax), __float_as_uint(pmax), false, false);
      pmax = fmaxf(__uint_as_float(rr[0]), __uint_as_float(rr[1])); }
    pmax += c;
    if (__builtin_expect(__all(pmax - m_reg <= THR2), 1)) { mn = m_reg; alpha = 1.f; }
    else { mn = fmaxf(m_reg, pmax); alpha = __builtin_amdgcn_exp2f(m_reg - mn); m_reg = mn; }
    const float off = c - mn;
#pragma unroll
    for (int r = 0; r < 16; ++r) p0[r] = p0[r] + off;
#pragma unroll
    for (int r = 0; r < 16; ++r) p1[r] = p1[r] + off;
#pragma unroll
    for (int r = 0; r < 16; ++r) p0[r] = __builtin_amdgcn_exp2f(p0[r]);
}
__device__ __forceinline__ void finishSM(f32x16& p0, f32x16& p1, float alpha, float& l_reg, bf16x8& pa0, bf16x8& pa1, bf16x8& pa2, bf16x8& pa3) {
#pragma unroll
    for (int r = 0; r < 16; ++r) p1[r] = __builtin_amdgcn_exp2f(p1[r]);
    float ps = 0;
#pragma unroll
    for (int r = 0; r < 16; ++r) ps += p0[r];
#pragma unroll
    for (int r = 0; r < 16; ++r) ps += p1[r];
    { auto rr = __builtin_amdgcn_permlane32_swap(__float_as_uint(ps), __float_as_uint(ps), false, false);
      ps = __uint_as_float(rr[0]) + __uint_as_float(rr[1]); }
    l_reg = l_reg * alpha + ps;
#define PK4(P, BASE, OUT) do { unsigned a0 = cvtpk(P[BASE + 0], P[BASE + 1]), a1 = cvtpk(P[BASE + 2], P[BASE + 3]);   \
    unsigned b0 = cvtpk(P[BASE + 4], P[BASE + 5]), b1 = cvtpk(P[BASE + 6], P[BASE + 7]);                              \
    auto r0 = __builtin_amdgcn_permlane32_swap(a0, b0, false, false); auto r1 = __builtin_amdgcn_permlane32_swap(a1, b1, false, false); \
    u32x4 w = {r0[0], r1[0], r0[1], r1[1]}; OUT = *reinterpret_cast<bf16x8*>(&w); } while (0)
    PK4(p0, 0, pa0); PK4(p0, 8, pa1); PK4(p1, 0, pa2); PK4(p1, 8, pa3);
#undef PK4
}
__device__ __forceinline__ void qkt(f32x16& p0, f32x16& p1, const char* Ks, const bf16x8* qr, int r32, int hi, int map) {
    p0 = f32x16{}; p1 = f32x16{};
#pragma unroll
    for (int d0 = 0; d0 < 4; ++d0) { const int cb = ((map * 4 + d0) * 16 + hi * 8) * 2;
        bf16x8 b0 = *reinterpret_cast<const bf16x8*>(Ks + KSWZ(r32, cb));
        bf16x8 b1 = *reinterpret_cast<const bf16x8*>(Ks + KSWZ(32 + r32, cb));
        p0 = __builtin_amdgcn_mfma_f32_32x32x16_bf16(b0, qr[d0], p0, 0, 0, 0);
        p1 = __builtin_amdgcn_mfma_f32_32x32x16_bf16(b1, qr[d0], p1, 0, 0, 0); }
}
__device__ __forceinline__ int v_st(int k, int c) { const int kk = (k & ~0xC) | ((k & 4) << 1) | ((k & 8) >> 1); return ((kk >> 3) * 4 + (c >> 5)) * 512 + ((kk & 7) * 32 + (c & 31)) * 2; }
__device__ __forceinline__ int v_rd_base(int lane) { return ((lane & 3) << 3) | (((lane >> 2) & 3) << 6) | (((lane >> 4) & 1) << 5) | (((lane >> 5) & 1) << 8); }
constexpr int v_rd_off(int d0, int ks, int half) { return d0 * 512 + ks * 4096 + half * 2048; }
template <int OFF> __device__ __forceinline__ s16x4 tr_read(int vb) {
    s16x4 r; asm volatile("ds_read_b64_tr_b16 %0, %1 offset:%2" : "=&v"(r) : "v"(vb), "i"(OFF) : "memory"); return r;
}
template <int D0> __device__ __forceinline__ void pv_one(f32x16& od, int vb, bf16x8 pa0, bf16x8 pa1, bf16x8 pa2, bf16x8 pa3) {
    const s16x4 l0 = tr_read<v_rd_off(D0, 0, 0)>(vb), h0 = tr_read<v_rd_off(D0, 0, 1)>(vb), l1 = tr_read<v_rd_off(D0, 1, 0)>(vb), h1 = tr_read<v_rd_off(D0, 1, 1)>(vb);
    const s16x4 l2 = tr_read<v_rd_off(D0, 2, 0)>(vb), h2 = tr_read<v_rd_off(D0, 2, 1)>(vb), l3 = tr_read<v_rd_off(D0, 3, 0)>(vb), h3 = tr_read<v_rd_off(D0, 3, 1)>(vb);
    asm volatile("s_waitcnt lgkmcnt(0)" ::: "memory"); SBAR();
#define PK(L, H) (bf16x8){L[0], L[1], L[2], L[3], H[0], H[1], H[2], H[3]}
    od = __builtin_amdgcn_mfma_f32_32x32x16_bf16(pa0, PK(l0, h0), od, 0, 0, 0);
    od = __builtin_amdgcn_mfma_f32_32x32x16_bf16(pa1, PK(l1, h1), od, 0, 0, 0);
    od = __builtin_amdgcn_mfma_f32_32x32x16_bf16(pa2, PK(l2, h2), od, 0, 0, 0);
    od = __builtin_amdgcn_mfma_f32_32x32x16_bf16(pa3, PK(l3, h3), od, 0, 0, 0);
#undef PK
}
__device__ __forceinline__ void pv_d0(f32x16* o, int vb, bf16x8 pa0, bf16x8 pa1, bf16x8 pa2, bf16x8 pa3) {
    pv_one<0>(o[0], vb, pa0, pa1, pa2, pa3); pv_one<1>(o[1], vb, pa0, pa1, pa2, pa3); pv_one<2>(o[2], vb, pa0, pa1, pa2, pa3); pv_one<3>(o[3], vb, pa0, pa1, pa2, pa3);
}
__device__ __forceinline__ int t5_bucket(int rel) {
    const int n = rel < 0 ? -rel : rel; int b;
    if (n < 8) b = n; else if (n < 12) b = 8; else if (n < 16) b = 9; else if (n < 23) b = 10; else if (n < 32) b = 11; else if (n < 46) b = 12; else if (n < 64) b = 13; else if (n < 91) b = 14; else b = 15;
    return b + (rel > 0 ? 16 : 0);
}
__device__ __forceinline__ void attn_unit(int b, int h, int qb, const bf16_t* __restrict__ P, bf16_t* __restrict__ mix, const float* __restrict__ relb, const float* __restrict__ subg, float lam, char* lds) {
    const int tid = threadIdx.x, wid = tid >> 6, lane = tid & 63, r32 = lane & 31, hi = lane >> 5, map = wid >> 2, wq = wid & 3;
    char* V_lds = lds; char* K_lds = lds + 2 * SHM_V;
    float* ws = (float*)(lds + OFF_WS) + wid * 64; float* li_l = ws; float* al_l = ws + 32;
    float* tbl = (float*)(lds + OFF_TBL);
    __syncthreads();
    for (int i = tid; i < 513; i += 512) tbl[i] = relb[t5_bucket(i - 256) * NH + h] * LOG2E;
    const float c_lo = relb[15 * NH + h] * LOG2E, c_hi = relb[31 * NH + h] * LOG2E;
    const int qpos0 = qb * 128 + wq * 32;
    const float* tblp = tbl + 256 - r32 + 4 * hi;
    float m_reg = -1e30f, l_reg = 0; f32x16 o[4] = {}; bf16x8 qr[4];
    const bf16_t* Qw = P + (size_t)(b * SEQ + qpos0 + r32) * LDP + Q_OFF + h * 128 + map * 64 + hi * 8;
#pragma unroll
    for (int d0 = 0; d0 < 4; ++d0) qr[d0] = *reinterpret_cast<const bf16x8*>(Qw + d0 * 16);
    const bf16_t* Kh = P + (size_t)(b * SEQ) * LDP + K_OFF + h * 128;
    const bf16_t* Vh = P + (size_t)(b * SEQ) * LDP + V_OFF + h * 128;
    const int sr = tid >> 4, sc = (tid & 15) * 8, vst0 = v_st(sr, sc), vst1 = v_st(32 + sr, sc);
    const int vb0 = (int)(uintptr_t)V_lds + v_rd_base(lane);
    struct { bf16x8 vs0, vs1, ks0, ks1; } sr_[2];
#define SLOAD(i, k0) do { sr_[i].vs0 = *reinterpret_cast<const bf16x8*>(&Vh[(size_t)((k0) + sr) * LDP + sc]); sr_[i].vs1 = *reinterpret_cast<const bf16x8*>(&Vh[(size_t)((k0) + 32 + sr) * LDP + sc]); \
    sr_[i].ks0 = *reinterpret_cast<const bf16x8*>(&Kh[(size_t)((k0) + sr) * LDP + sc]); sr_[i].ks1 = *reinterpret_cast<const bf16x8*>(&Kh[(size_t)((k0) + 32 + sr) * LDP + sc]); } while (0)
#define SWRITE(bq, i) do { *(bf16x8*)(V_lds + (bq) * SHM_V + vst0) = sr_[i].vs0;          \
    *(bf16x8*)(V_lds + (bq) * SHM_V + vst1) = sr_[i].vs1; int kc = sc * 2;               \
    *(bf16x8*)(K_lds + (bq) * SHM_K + KSWZ(sr, kc)) = sr_[i].ks0;                       \
    *(bf16x8*)(K_lds + (bq) * SHM_K + KSWZ(32 + sr, kc)) = sr_[i].ks1; } while (0)
#define SWAIT() asm volatile("s_waitcnt vmcnt(4)" ::: "memory")
#define RESC(a) do { if (__any((a) < 1.f)) { if (hi == 0) al_l[r32] = (a); asm volatile("s_waitcnt lgkmcnt(0)" ::: "memory"); \
    _Pragma("unroll") for (int d = 0; d < 4; ++d) _Pragma("unroll") for (int r = 0; r < 16; ++r) o[d][r] *= al_l[crow(r, hi)]; } } while (0)
    f32x16 pA0, pA1, pB0, pB1; float mnA, mnB, alA, alB; bf16x8 pa0, pa1, pa2, pa3; constexpr int NT = SEQ / 64;
    constexpr int SE = 0, SO = 1;
    SLOAD(SE, 0); asm volatile("s_waitcnt vmcnt(0)" ::: "memory"); SWRITE(0, SE); __syncthreads();
    qkt(pA0, pA1, K_lds, qr, r32, hi, map); partialSM(pA0, pA1, m_reg, mnA, alA, 0 - qpos0, c_lo, c_hi, tblp);
    SLOAD(SO, 64); SLOAD(SE, 128);
    SWAIT(); SWRITE(1, SO); __syncthreads();
    for (int j = 1; j + 1 < NT; j += 2) {
        SBAR(); qkt(pB0, pB1, K_lds + SHM_K, qr, r32, hi, map);
        finishSM(pA0, pA1, alA, l_reg, pa0, pa1, pa2, pa3); SBAR();
        SLOAD(SO, (j + 2) * 64); SBAR();
        pv_d0(o, vb0, pa0, pa1, pa2, pa3); partialSM(pB0, pB1, m_reg, mnB, alB, j * 64 - qpos0, c_lo, c_hi, tblp);
        __syncthreads(); SWAIT(); SWRITE(0, SE);
        RESC(alB); __syncthreads();
        SBAR(); qkt(pA0, pA1, K_lds, qr, r32, hi, map);
        finishSM(pB0, pB1, alB, l_reg, pa0, pa1, pa2, pa3); SBAR();
        if (j + 3 < NT) SLOAD(SE, (j + 3) * 64); SBAR();
        pv_d0(o, vb0 + SHM_V, pa0, pa1, pa2, pa3); partialSM(pA0, pA1, m_reg, mnA, alA, (j + 1) * 64 - qpos0, c_lo, c_hi, tblp);
        __syncthreads(); SWAIT(); SWRITE(1, SO);
        RESC(alA); __syncthreads();
    }
    SBAR(); qkt(pB0, pB1, K_lds + SHM_K, qr, r32, hi, map);
    finishSM(pA0, pA1, alA, l_reg, pa0, pa1, pa2, pa3); SBAR();
    pv_d0(o, vb0, pa0, pa1, pa2, pa3); partialSM(pB0, pB1, m_reg, mnB, alB, (NT - 1) * 64 - qpos0, c_lo, c_hi, tblp);
    __syncthreads(); RESC(alB);
    finishSM(pB0, pB1, alB, l_reg, pa0, pa1, pa2, pa3); SBAR();
    pv_d0(o, vb0 + SHM_V, pa0, pa1, pa2, pa3);
    if (hi == 0) li_l[r32] = l_reg; asm volatile("s_waitcnt lgkmcnt(0)" ::: "memory");
    float rli[16];
#pragma unroll
    for (int r = 0; r < 16; ++r) rli[r] = __builtin_amdgcn_rcpf(li_l[crow(r, hi)]);
    __syncthreads();
    float* X = (float*)lds;
    if (map == 1) {
#pragma unroll
        for (int d0 = 0; d0 < 4; ++d0)
#pragma unroll
            for (int r = 0; r < 16; ++r) X[(d0 * 16 + r) * 256 + wq * 64 + lane] = o[d0][r] * rli[r];
    }
    __syncthreads();
    if (map == 0) {
        float sg[4];
#pragma unroll
        for (int d0 = 0; d0 < 4; ++d0) sg[d0] = subg[d0 * 32 + r32] * SUBLN_MUL;
        bf16_t* Ob = mix + (size_t)(b * SEQ + qpos0) * DM + h * 128 + r32;
#pragma unroll
        for (int r = 0; r < 16; ++r) {
            float v[4]; float ss = 0.f;
#pragma unroll
            for (int d0 = 0; d0 < 4; ++d0) { v[d0] = o[d0][r] * rli[r] - lam * X[(d0 * 16 + r) * 256 + wq * 64 + lane]; ss += v[d0] * v[d0]; }
#pragma unroll
            for (int s = 1; s < 32; s <<= 1) ss += __shfl_xor(ss, s);
            const float rms = __builtin_amdgcn_rsqf(ss * (1.0f / 128.0f) + LN_EPS);
            const int orow = crow(r, hi);
#pragma unroll
            for (int d0 = 0; d0 < 4; ++d0) Ob[(size_t)orow * DM + d0 * 32] = (bf16_t)(cvtpk(v[d0] * rms * sg[d0], 0.f) & 0xffffu);
        }
    }
#undef SLOAD
#undef SWRITE
#undef SWAIT
#undef RESC
}

constexpr int SG_STRIDE = 272;
__device__ __forceinline__ void sg_unit(int b, int c, int g, const bf16_t* __restrict__ P, bf16_t* __restrict__ mix, const float* __restrict__ lng, const float* __restrict__ lnb,
                                        const bf16_t* __restrict__ sgw, const float* __restrict__ sgb, char* lds) {
    const int tid = threadIdx.x, wid = tid >> 6, lane = tid & 63, r32 = lane & 31, hi = lane >> 5;
    const size_t row0 = (size_t)b * SEQ + (size_t)c * 128;
    __syncthreads();
    {
        const int q = tid >> 2, part = tid & 3;
        const bf16_t* src = P + (row0 + q) * LDP + G_OFF + g * 128 + part * 32;
        float v[32];
#pragma unroll
        for (int j = 0; j < 4; ++j) { const u32x4 w = *reinterpret_cast<const u32x4*>(src + j * 8);
            v[j * 8 + 0] = bflo(w.x); v[j * 8 + 1] = bfhi(w.x); v[j * 8 + 2] = bflo(w.y); v[j * 8 + 3] = bfhi(w.y); v[j * 8 + 4] = bflo(w.z); v[j * 8 + 5] = bfhi(w.z); v[j * 8 + 6] = bflo(w.w); v[j * 8 + 7] = bfhi(w.w); }
        float s = 0.f;
#pragma unroll
        for (int j = 0; j < 32; ++j) s += v[j];
        s += __shfl_xor(s, 1); s += __shfl_xor(s, 2);
        const float mean = s * (1.0f / 128.0f); float s2 = 0.f;
#pragma unroll
        for (int j = 0; j < 32; ++j) { v[j] -= mean; s2 += v[j] * v[j]; }
        s2 += __shfl_xor(s2, 1); s2 += __shfl_xor(s2, 2);
        const float rstd = __builtin_amdgcn_rsqf(s2 * (1.0f / 128.0f) + LN_EPS);
        const float* gp = lng + g * 128 + part * 32; const float* bp = lnb + g * 128 + part * 32;
#pragma unroll
        for (int j = 0; j < 32; ++j) { const float y = v[j] * rstd * gp[j] + bp[j];
            *(bf16_t*)(lds + (part * 32 + j) * SG_STRIDE + q * 2) = (bf16_t)(cvtpk(y, 0.f) & 0xffffu); }
    }
    __syncthreads();
    const int pblk = wid >> 1, eblk = (wid & 1) * 64;
    f32x16 acc0 = {}, acc1 = {};
    const bf16_t* Wp = sgw + ((size_t)g * 128 + pblk * 32 + r32) * 128 + hi * 8;
#pragma unroll
    for (int ks = 0; ks < 8; ++ks) {
        const bf16x8 a = *reinterpret_cast<const bf16x8*>(Wp + ks * 16);
        const bf16x8 b0 = *reinterpret_cast<const bf16x8*>(lds + (eblk + r32) * SG_STRIDE + (ks * 16 + hi * 8) * 2);
        const bf16x8 b1 = *reinterpret_cast<const bf16x8*>(lds + (eblk + 32 + r32) * SG_STRIDE + (ks * 16 + hi * 8) * 2);
        acc0 = __builtin_amdgcn_mfma_f32_32x32x16_bf16(a, b0, acc0, 0, 0, 0);
        acc1 = __builtin_amdgcn_mfma_f32_32x32x16_bf16(a, b1, acc1, 0, 0, 0);
    }
#pragma unroll
    for (int r = 0; r < 16; ++r) { const int p = pblk * 32 + crow(r, hi); const float bs = sgb[g * 128 + p];
        const bf16_t* up = P + (row0 + p) * LDP + U_OFF + g * 128 + eblk + r32;
        bf16_t* op = mix + (row0 + p) * DM + 1024 + g * 128 + eblk + r32;
        op[0]  = (bf16_t)(cvtpk(bf2f(up[0])  * (acc0[r] + bs), 0.f) & 0xffffu);
        op[32] = (bf16_t)(cvtpk(bf2f(up[32]) * (acc1[r] + bs), 0.f) & 0xffffu); }
}
#undef KSWZ
#undef SBAR
}

constexpr int NWAVES = 8;
constexpr int N_PHASES = 8;
struct Args { const float* in[24]; float* out; unsigned char* ws; int ph_lo, ph_hi; };
static_assert(sizeof(Args) == 24 * 8 + 8 + 8 + 8, "Args has no padding");

__global__ void __launch_bounds__(NWAVES * 64, 2) mega(Args args) {
    extern __shared__ __attribute__((aligned(16))) unsigned char lds[];
    LAS unsigned char* L = (LAS unsigned char*)lds;
    volatile LAS unsigned* MISC = (volatile LAS unsigned*)(L + MISC_OFF);
    const int tid = threadIdx.x, lane = tid & 63, wave = __builtin_amdgcn_readfirstlane(tid >> 6);
    const int G = gridDim.x; const int bx = blockIdx.x; const int vcu = (G % 8 == 0) ? (bx % 8) * (G / 8) + bx / 8 : bx;
    unsigned char* ws = args.ws;
    GAS unsigned* ctl = (GAS unsigned*)(ws + WS_CTL);
    const float* x = args.in[0]; const float* w_in = args.in[1]; const float* w_out = args.in[2];
    const float* ln1g = args.in[3]; const float* ln1b = args.in[4]; const float* ln2g = args.in[5]; const float* ln2b = args.in[6];
    const float* relb = args.in[7]; const float* lq1 = args.in[8]; const float* lk1 = args.in[9]; const float* lq2 = args.in[10]; const float* lk2 = args.in[11];
    const float* subg = args.in[12]; const float* sglng = args.in[13]; const float* sglnb = args.in[14]; const float* sgw = args.in[15]; const float* sgb = args.in[16];
    const float* wrg = args.in[17]; const float* brg = args.in[18]; const float* wre = args.in[19]; const float* bre = args.in[20];
    const float* wg = args.in[21]; const float* wu = args.in[22]; const float* wd = args.in[23];
    float* out = args.out;
    bf16_t* WinT = (bf16_t*)(ws + WS_WIN); bf16_t* WoutT = (bf16_t*)(ws + WS_WOUT); bf16_t* WguT = (bf16_t*)(ws + WS_WGU); bf16_t* WdT = (bf16_t*)(ws + WS_WD);
    bf16_t* sgwb = (bf16_t*)(ws + WS_SGW); bf16_t* xb = (bf16_t*)(ws + WS_XB); bf16_t* Pb = (bf16_t*)(ws + WS_P); bf16_t* mix = (bf16_t*)(ws + WS_MIX);
    float* Y = (float*)(ws + WS_Y); float* H1 = (float*)(ws + WS_H1); bf16_t* H1B = (bf16_t*)(ws + WS_H1B); bf16_t* HB = (bf16_t*)(ws + WS_HB); bf16_t* OB = (bf16_t*)(ws + WS_O);
    int* tokl = (int*)(ws + WS_TOKL); float* tokw = (float*)(ws + WS_TOKW);

    for (int u = tid; u < (LDS_BYTES - MISC_OFF) / 4; u += NWAVES * 64) ((LAS unsigned*)(L + MISC_OFF))[u] = 0u;
    __syncthreads();
    XcdBarrier bar; bar.bar = (unsigned*)(ws + WS_CTL) + CW_BAR; bar.x = 0; bar.st = nullptr;
    if (MK_N_LAUNCHES == 1) bar = xcd_barrier_post((unsigned*)(ws + WS_CTL) + CW_BAR, MISC + 8);
    const int lo = args.ph_lo, hi_ = args.ph_hi;
#ifndef PHASE_MASK
#define PHASE_MASK 0xff
#endif
#define IN(k) (((PHASE_MASK >> (k)) & 1) && lo <= (k) && (k) < hi_)
#define GRID_BAR(k) do { if (IN(k) && IN((k) + 1)) xcd_barrier(bar); } while (0)
    const int gw = vcu * NWAVES + wave, NGW = G * NWAVES;

    if (IN(0)) {
        LAS float* scr = (LAS float*)(L + wave * 16384);
        constexpr int I_IN = 32 * 160, I_OUT = 32 * 64, I_G = 32 * 256, I_U = I_G, I_D = 32 * 256;
        constexpr int NITEMS = I_IN + I_OUT + I_G + I_U + I_D;
        for (int it = gw; it < NITEMS; it += NGW) {
            int r = it;
            if (r < I_IN) { const int kb = r / 160, nb = r % 160; tr_item(w_in + (size_t)kb * 64 * INW + nb * 32, INW, WinT + (size_t)nb * 32 * DM + kb * 64, DM, scr, lane); continue; } r -= I_IN;
            if (r < I_OUT) { const int kb = r / 64, nb = r % 64; tr_item(w_out + (size_t)kb * 64 * DM + nb * 32, DM, WoutT + (size_t)nb * 32 * DM + kb * 64, DM, scr, lane); continue; } r -= I_OUT;
            if (r < I_G + I_U) { const bool up = r >= I_G; if (up) r -= I_G; const int e = r / 256, q = r % 256, kb = q / 8, nb = q % 8;
                const float* src = (up ? wu : wg) + (size_t)e * DM * DEXP + (size_t)kb * 64 * DEXP + nb * 32;
                const int drow = e * 512 + (nb >> 2) * 256 + (up ? 128 : 0) + (nb & 3) * 32;
                tr_item(src, DEXP, WguT + (size_t)drow * DM + kb * 64, DM, scr, lane); continue; } r -= I_G + I_U;
            { const int e = r / 256, q = r % 256, kb = q / 64, nb = q % 64;
              tr_item(wd + (size_t)e * DEXP * DM + (size_t)kb * 64 * DM + nb * 32, DM, WdT + ((size_t)e * DM + nb * 32) * DEXP + kb * 64, DEXP, scr, lane); }
        }
        const size_t gt = (size_t)vcu * (NWAVES * 64) + tid, NGT = (size_t)G * NWAVES * 64;
        for (size_t i = gt; i < (size_t)TOK * DM / 8; i += NGT) { const f32x4 a = *(const f32x4*)(x + i * 8), b = *(const f32x4*)(x + i * 8 + 4);
            u32x4 w; w.x = cvt_pk_bf16(a[0], a[1]); w.y = cvt_pk_bf16(a[2], a[3]); w.z = cvt_pk_bf16(b[0], b[1]); w.w = cvt_pk_bf16(b[2], b[3]); *(u32x4*)(xb + i * 8) = w; }
        for (size_t i = gt; i < (size_t)8 * 128 * 128 / 8; i += NGT) { const f32x4 a = *(const f32x4*)(sgw + i * 8), b = *(const f32x4*)(sgw + i * 8 + 4);
            u32x4 w; w.x = cvt_pk_bf16(a[0], a[1]); w.y = cvt_pk_bf16(a[2], a[3]); w.z = cvt_pk_bf16(b[0], b[1]); w.w = cvt_pk_bf16(b[2], b[3]); *(u32x4*)(sgwb + i * 8) = w; }
    }
    GRID_BAR(0);

    if (IN(1)) {
        pg8::SchedDense S; S.init(TOK, INW, DM, G, bx, xb, WinT);
        EpiProj E{Pb};
        pg8::gemm_phase<EpiProj, pg8::SchedDense, false>(L, DM, S, E, nullptr);
    }
    GRID_BAR(1);

    if (IN(2)) {
        float lam;
        { const float a = lane < 64 ? lq1[lane] * lk1[lane] : 0.f, c = lq2[lane] * lk2[lane];
          lam = __expf(wave_sum(a)) - __expf(wave_sum(c)) + LAM_INIT; }
        for (int u = vcu; u < 512; u += G) { const int bh = u >> 5, qb = u & 31; att::attn_unit(bh >> 3, bh & 7, qb, Pb, mix, relb, subg, lam, (char*)lds); }
        for (int u = vcu; u < 512; u += G) { const int g = u & 7, c = (u >> 3) & 31, b = u >> 8; att::sg_unit(b, c, g, Pb, mix, sglng, sglnb, sgwb, sgb, (char*)lds); }
        __syncthreads();
    }
    GRID_BAR(2);

    if (IN(3)) {
        pg8::SchedDense S; S.init(TOK, DM, DM, G, bx, mix, WoutT);
        EpiY E{x, Y};
        pg8::gemm_phase<EpiY, pg8::SchedDense, false>(L, DM, S, E, nullptr);
    }
    GRID_BAR(3);

    if (IN(4)) {
        for (int t = gw; t < TOK; t += NGW) {
            const f32x4* yr = (const f32x4*)(Y + (size_t)t * DM) + lane;
            f32x4 v[8]; float s = 0.f;
#pragma unroll
            for (int j = 0; j < 8; ++j) { v[j] = yr[64 * j]; s += (v[j][0] + v[j][1]) + (v[j][2] + v[j][3]); }
            const float mean = wave_sum(s) * (1.0f / DM); float s2 = 0.f;
#pragma unroll
            for (int j = 0; j < 8; ++j) { v[j] = v[j] - mean; s2 += (v[j][0] * v[j][0] + v[j][1] * v[j][1]) + (v[j][2] * v[j][2] + v[j][3] * v[j][3]); }
            const float rstd = 1.0f / sqrtf(wave_sum(s2) * (1.0f / DM) + LN_EPS);
            float lg[4] = {0.f, 0.f, 0.f, 0.f};
#pragma unroll
            for (int j = 0; j < 8; ++j) { const int col = 256 * j + 4 * lane; const f32x4 gg = *(const f32x4*)(ln1g + col), bb = *(const f32x4*)(ln1b + col);
                v[j] = v[j] * rstd * gg + bb;
                *(f32x4*)(H1 + (size_t)t * DM + col) = v[j];
                u32x2 w; w.x = cvt_pk_bf16(v[j][0], v[j][1]); w.y = cvt_pk_bf16(v[j][2], v[j][3]); *(u32x2*)(H1B + (size_t)t * DM + col) = w;
#pragma unroll
                for (int c = 0; c < 4; ++c) { const f32x4 wr4 = *(const f32x4*)(wrg + (size_t)(col + c) * 4);
#pragma unroll
                    for (int q = 0; q < 4; ++q) lg[q] += v[j][c] * wr4[q]; } }
#pragma unroll
            for (int q = 0; q < 4; ++q) lg[q] = wave_sum(lg[q]) + brg[q];
            int gi = 0; float gm = lg[0];
#pragma unroll
            for (int q = 1; q < 4; ++q) if (lg[q] > gm) { gm = lg[q]; gi = q; }
            float gs = 0.f;
#pragma unroll
            for (int q = 0; q < 4; ++q) gs += __expf(lg[q] - gm);
            const float ggate = 1.0f / gs;
            gi = __builtin_amdgcn_readfirstlane(gi);
            float el[8] = {0.f, 0.f, 0.f, 0.f, 0.f, 0.f, 0.f, 0.f};
            const float* wre_g = wre + (size_t)gi * DM * EPG;
#pragma unroll
            for (int j = 0; j < 8; ++j) { const int col = 256 * j + 4 * lane;
#pragma unroll
                for (int c = 0; c < 4; ++c) { const f32x4 w0 = *(const f32x4*)(wre_g + (size_t)(col + c) * 8), w1 = *(const f32x4*)(wre_g + (size_t)(col + c) * 8 + 4);
#pragma unroll
                    for (int q = 0; q < 4; ++q) { el[q] += v[j][c] * w0[q]; el[4 + q] += v[j][c] * w1[q]; } } }
#pragma unroll
            for (int q = 0; q < 8; ++q) el[q] = wave_sum(el[q]) + bre[gi * EPG + q];
            int i1 = 0; float v1 = el[0];
#pragma unroll
            for (int q = 1; q < 8; ++q) if (el[q] > v1) { v1 = el[q]; i1 = q; }
            int i2 = -1; float v2 = -3.0e38f;
#pragma unroll
            for (int q = 0; q < 8; ++q) if (q != i1 && el[q] > v2) { v2 = el[q]; i2 = q; }
            const float e2 = __expf(v2 - v1); const float w1 = ggate / (1.0f + e2), w2 = ggate * e2 / (1.0f + e2);
            if (lane == 0) {
                const int ex1 = gi * EPG + i1, ex2 = gi * EPG + i2;
                const unsigned p1 = __hip_atomic_fetch_add(ctl + CW_CNT + ex1, 1u, RLX_AGENT);
                const unsigned p2 = __hip_atomic_fetch_add(ctl + CW_CNT + ex2, 1u, RLX_AGENT);
                tokl[ex1 * TOK + p1] = t; tokw[ex1 * TOK + p1] = w1;
                tokl[ex2 * TOK + p2] = t | (1 << 16); tokw[ex2 * TOK + p2] = w2;
            }
        }
    }
    GRID_BAR(4);

    LAS int* tab = (LAS int*)(L + LDSX_OFF);
    if (IN(5) || IN(6)) {
        __syncthreads();
        if (tid == 0) { int nt = 0;
            for (int e = 0; e < NEXP; ++e) { const int c = (int)__hip_atomic_load(ctl + CW_CNT + e, RLX_AGENT); const int n = (c + 255) >> 8;
                for (int l = 0; l < n; ++l) { tab[1 + 4 * nt] = e; tab[2 + 4 * nt] = l; tab[3 + 4 * nt] = (c - l * 256) < 256 ? (c - l * 256) : 256; tab[4 + 4 * nt] = 0; ++nt; } }
            tab[0] = nt; }
        __syncthreads();
    }
    if (IN(5)) {
        SchedMoE S{tab, 2, G, bx, (const char*)H1B, (const char*)WguT, (size_t)256 * DM * 2, true};
        EpiGU E{HB, tokw};
        pg8::gemm_phase<EpiGU, SchedMoE, true>(L, DM, S, E, tokl);
    }
    GRID_BAR(5);
    if (IN(6)) {
        SchedMoE S{tab, 8, G, bx, (const char*)HB, (const char*)WdT, (size_t)256 * DEXP * 2, false};
        EpiDown E{OB, tokl};
        pg8::gemm_phase<EpiDown, SchedMoE, false>(L, DEXP, S, E, nullptr);
    }
    GRID_BAR(6);

    if (IN(7)) {
        for (int t = gw; t < TOK; t += NGW) {
            f32x4 v[8]; float s = 0.f;
#pragma unroll
            for (int j = 0; j < 8; ++j) { const int col = 256 * j + 4 * lane; const f32x4 h = *(const f32x4*)(H1 + (size_t)t * DM + col);
                const u32x2 a = *(const u32x2*)(OB + (size_t)t * DM + col), b = *(const u32x2*)(OB + ((size_t)TOK + t) * DM + col);
                v[j][0] = h[0] * DN_ALPHA + (bflo(a.x) + bflo(b.x)); v[j][1] = h[1] * DN_ALPHA + (bfhi(a.x) + bfhi(b.x));
                v[j][2] = h[2] * DN_ALPHA + (bflo(a.y) + bflo(b.y)); v[j][3] = h[3] * DN_ALPHA + (bfhi(a.y) + bfhi(b.y));
                s += (v[j][0] + v[j][1]) + (v[j][2] + v[j][3]); }
            const float mean = wave_sum(s) * (1.0f / DM); float s2 = 0.f;
#pragma unroll
            for (int j = 0; j < 8; ++j) { v[j] = v[j] - mean; s2 += (v[j][0] * v[j][0] + v[j][1] * v[j][1]) + (v[j][2] * v[j][2] + v[j][3] * v[j][3]); }
            const float rstd = 1.0f / sqrtf(wave_sum(s2) * (1.0f / DM) + LN_EPS);
#pragma unroll
            for (int j = 0; j < 8; ++j) { const int col = 256 * j + 4 * lane; const f32x4 gg = *(const f32x4*)(ln2g + col), bb = *(const f32x4*)(ln2b + col);
                *(f32x4*)(out + (size_t)t * DM + col) = v[j] * rstd * gg + bb; }
        }
    }
#undef IN
#undef GRID_BAR
}

extern "C" void kernel_launch(void* const* d_in, const int* in_sizes, int n_in, void* d_out, int out_size, void* d_ws, size_t ws_size, hipStream_t stream) {
    static int grid = 0;
    if (grid == 0) {
        if (n_in != 24 || out_size != TOK * DM || ws_size < WS_END) { fprintf(stderr, "kernel_launch: unexpected shapes (n_in %d out %d ws %zu)\n", n_in, out_size, ws_size); grid = -1; return; }
        int dev = 0, cus = 0, per_cu = 0;
        if (hipGetDevice(&dev) != hipSuccess || hipDeviceGetAttribute(&cus, hipDeviceAttributeMultiprocessorCount, dev) != hipSuccess) { grid = -1; return; }
        if (hipFuncSetAttribute((const void*)mega, hipFuncAttributeMaxDynamicSharedMemorySize, LDS_BYTES) != hipSuccess) { fprintf(stderr, "kernel_launch: hipFuncSetAttribute failed\n"); grid = -1; return; }
        if (hipOccupancyMaxActiveBlocksPerMultiprocessor(&per_cu, (const void*)mega, NWAVES * 64, LDS_BYTES) != hipSuccess || per_cu < 1)
            fprintf(stderr, "kernel_launch: occupancy query reports %d workgroups per CU\n", per_cu);
        (void)hipGetLastError();
        grid = cus;
    }
    if (grid < 0) return;
    if (hipMemsetAsync((char*)d_ws + WS_CTL, 0, CTL_ZERO_BYTES, stream) != hipSuccess) return;
    Args a{};
    for (int i = 0; i < 24; ++i) a.in[i] = (const float*)d_in[i];
    a.out = (float*)d_out; a.ws = (unsigned char*)d_ws;
    if (MK_N_LAUNCHES == 1) { a.ph_lo = 0; a.ph_hi = N_PHASES; hipLaunchKernelGGL(mega, dim3(grid), dim3(NWAVES * 64), LDS_BYTES, stream, a); }
    else { for (int p = 0; p < N_PHASES; ++p) { a.ph_lo = p; a.ph_hi = p + 1; hipLaunchKernelGGL(mega, dim3(grid), dim3(NWAVES * 64), LDS_BYTES, stream, a); } }
}
```

```cpp
#include <hip/hip_runtime.h>
#include <cstdio>
#include <cstdint>

#ifndef MK_N_LAUNCHES
#define MK_N_LAUNCHES 1
#endif

#define GAS __attribute__((address_space(1)))
#define LAS __attribute__((address_space(3)))
typedef unsigned short bf16_t;
typedef short bf16x8 __attribute__((ext_vector_type(8)));
typedef short s16x4 __attribute__((ext_vector_type(4)));
typedef float f32x2 __attribute__((ext_vector_type(2)));
typedef float f32x4 __attribute__((ext_vector_type(4)));
typedef float f32x16 __attribute__((ext_vector_type(16)));
typedef unsigned u32x2 __attribute__((ext_vector_type(2)));
typedef unsigned u32x4 __attribute__((ext_vector_type(4)));

constexpr int TOK = 8192, SEQ = 4096, DM = 2048, INW = 5120, NH = 8;
constexpr int NEXP = 32, DEXP = 256, EPG = 8;
constexpr int Q_OFF = 0, K_OFF = 1024, V_OFF = 2048, U_OFF = 3072, G_OFF = 4096;
constexpr float DN_ALPHA = 1.189207115002721f;
constexpr float LN_EPS = 1e-5f;
constexpr float LOG2E = 1.4426950408889634f;
constexpr float QSCALE = 0.125f * LOG2E;
constexpr float SUBLN_MUL = 0.8f;
constexpr float LAM_INIT = 0.2f;

constexpr size_t MiB = 1u << 20;
constexpr size_t WS_CTL = 0, CTL_ZERO_BYTES = 1 * MiB;
constexpr size_t WS_TOKL = 1 * MiB, WS_TOKW = 2 * MiB;
constexpr size_t WS_SGW = 3 * MiB;
constexpr size_t WS_WRH = 3 * MiB + 512 * 1024, WS_WRL = 3 * MiB + 768 * 1024;
constexpr size_t WS_WGU = 4 * MiB;
constexpr size_t WS_WD = 68 * MiB;
constexpr size_t WS_WIN = 100 * MiB;
constexpr size_t WS_WOUT = 120 * MiB;
constexpr size_t WS_XB = 128 * MiB;
constexpr size_t WS_MIX = 160 * MiB;
constexpr size_t WS_P = 192 * MiB;
constexpr size_t WS_H1 = 100 * MiB;
constexpr size_t WS_H1B = 164 * MiB;
constexpr size_t WS_HB = 196 * MiB;
constexpr size_t WS_Y = 208 * MiB;
constexpr size_t WS_O = 208 * MiB;
constexpr size_t WS_END = 272 * MiB;
constexpr int CW_CNT = 1024;
constexpr int CW_BAR = 4096;

constexpr int RING_BYTES = 131072;
constexpr int LDSX_OFF = RING_BYTES;
constexpr int MISC_OFF = RING_BYTES + 8192;
constexpr int LDS_BYTES = 147456;

#define RLX_AGENT __ATOMIC_RELAXED, __HIP_MEMORY_SCOPE_AGENT
#define LDS_WAIT() asm volatile("s_waitcnt lgkmcnt(0)" ::: "memory")
#define VM_WAIT() asm volatile("s_waitcnt vmcnt(0)" ::: "memory")

__device__ __forceinline__ unsigned cvt_pk_bf16(float lo, float hi) { unsigned r; asm volatile("v_cvt_pk_bf16_f32 %0, %1, %2" : "=v"(r) : "v"(lo), "v"(hi)); return r; }
__device__ __forceinline__ float bf2f(unsigned short b) { return __uint_as_float(((unsigned)b) << 16); }
__device__ __forceinline__ float bflo(unsigned w) { return __uint_as_float(w << 16); }
__device__ __forceinline__ float bfhi(unsigned w) { return __uint_as_float(w & 0xffff0000u); }

namespace pg8 {
constexpr int BM = 256, BK = 64, HALF = 128, HTB = HALF * BK * 2, NXCD = 8, WGM = 8;
__host__ __device__ __forceinline__ int lds_byte(int r, int c) { const int st = (r >> 4) * 2 + (c >> 5), rr = r & 15, cc = c & 31, ob = rr * 64 + cc * 2; return st * 1024 + (ob ^ (((ob >> 9) & 1) << 5)); }
__host__ __device__ __forceinline__ void stage_rc(int b, int& R, int& C) { const int st = b / 1024, sb = b % 1024, swz = sb ^ (((sb >> 9) & 1) << 5); R = (st >> 1) * 16 + swz / 64; C = (st & 1) * 32 + (swz % 64) / 2; }
__host__ __device__ __forceinline__ int perm32(int rho) { const int n = rho >> 4, i = rho & 15; return 8 * (i >> 2) + 4 * n + (i & 3); }

struct Unit { int pm, pn; const char* A; const char* B; int aux0, aux1; };

struct SchedDense {
    int nM, nN, nwg, G, c; const char* A; const char* B; size_t ta, tb;
    __device__ __forceinline__ void init(int M, int N, int K, int G_, int c_, const void* A_, const void* B_) { nM = M / BM; nN = N / BM; nwg = nM * nN; G = G_; c = c_; A = (const char*)A_; B = (const char*)B_; ta = (size_t)BM * K * 2; tb = ta; }
    __device__ __forceinline__ bool next(int i, Unit& u) const {
        const long L = (long)i * G + c; if (L >= nwg) return false;
        int wgid = (int)L; { const int q = nwg / NXCD, r = nwg % NXCD, xcd = wgid % NXCD, off = wgid / NXCD; wgid = (xcd < r ? xcd * (q + 1) : r * (q + 1) + (xcd - r) * q) + off; }
        const int nig = WGM * nN, gid = wgid / nig, fm = gid * WGM, gsz = (nM - fm) < WGM ? (nM - fm) : WGM;
        u.pm = fm + ((wgid % nig) % gsz); u.pn = (wgid % nig) / gsz; u.A = A + (size_t)u.pm * ta; u.B = B + (size_t)u.pn * tb; u.aux0 = 0; u.aux1 = 0; return true;
    }
};

template <class Epi, class Sched, bool GATHER>
__device__ __forceinline__ void gemm_phase(LAS unsigned char* lds, const int K, const Sched& S, const Epi& E, const int* gtok  ) {
    const int tid = threadIdx.x, wid = __builtin_amdgcn_readfirstlane(tid >> 6), lane = tid & 63, wr = wid >> 2, wc = wid & 3, fr = lane & 15, fq = lane >> 4;
    const int nt = K / BK;
    unsigned voffA[2][2], voffB[2]; int RA[2], CA[2];
#pragma unroll
    for (int i = 0; i < 2; ++i) { int R, C; stage_rc(tid * 16 + i * 8192, R, C); const int Rb = Epi::PERM ? ((R & ~31) + perm32(R & 31)) : R;
        RA[i] = R; CA[i] = C;
        voffA[0][i] = (unsigned)(R * K + C) * 2u; voffA[1][i] = (unsigned)((R + HALF) * K + C) * 2u; voffB[i] = (unsigned)(Rb * K + C) * 2u; }
    const size_t kstep = (size_t)(BK * 2);
    const size_t hstep = (size_t)HALF * K * 2;
    const unsigned ldsw = (unsigned)wid * 1024u;
    const int aoff = lds_byte(wr * 64 + fr, fq * 8), boff = lds_byte(wc * 32 + fr, fq * 8);
#define PG8_SA(b, h) (((b) * 2 + (h)) * HTB)
#define PG8_SB(b, h) ((4 + (b) * 2 + (h)) * HTB)
#define PG8_STAGE(bufoff, gbase, voff) do { _Pragma("unroll") for (int _i = 0; _i < 2; ++_i) \
        __builtin_amdgcn_global_load_lds((const unsigned*)((const char*)(gbase) + (voff)[_i]), (LAS unsigned*)(lds + (bufoff) + ldsw + _i * 8192), 16, 0, 0); } while (0)
#define PG8_LDA(dst, b, h) do { _Pragma("unroll") for (int m = 0; m < 4; ++m) _Pragma("unroll") for (int k = 0; k < 2; ++k) dst[m][k] = *(const LAS bf16x8*)(lds + PG8_SA(b, h) + aoff + m * 2048 + k * 1024); } while (0)
#define PG8_LDB(dst, b, h) do { _Pragma("unroll") for (int n = 0; n < 2; ++n) _Pragma("unroll") for (int k = 0; k < 2; ++k) dst[n][k] = *(const LAS bf16x8*)(lds + PG8_SB(b, h) + boff + n * 2048 + k * 1024); } while (0)
#define PG8_MMA(ai, bj, At, Bt) do { __builtin_amdgcn_s_setprio(1); _Pragma("unroll") for (int m = 0; m < 4; ++m) _Pragma("unroll") for (int n = 0; n < 2; ++n) _Pragma("unroll") for (int k = 0; k < 2; ++k) \
        acc[ai][bj][m][n] = __builtin_amdgcn_mfma_f32_16x16x32_bf16(Bt[n][k], At[m][k], acc[ai][bj][m][n], 0, 0, 0); __builtin_amdgcn_s_setprio(0); } while (0)
#define PG8_WAIT_V(n) asm volatile("s_waitcnt vmcnt(" #n ")" ::: "memory")
#define PG8_WAIT_L(n) asm volatile("s_waitcnt lgkmcnt(" #n ")" ::: "memory")
#define PG8_BAR __builtin_amdgcn_s_barrier()
#define PG8_SCHED __builtin_amdgcn_sched_barrier(0)
    Unit cur, nxt; int ui = 0;
    if (!S.next(0, cur)) return;
    f32x4 acc[2][2][4][2];
    bf16x8 At[4][2], B0[2][2], B1[2][2];
    for (;;) {
#pragma unroll
        for (int a = 0; a < 2; ++a)
#pragma unroll
            for (int b = 0; b < 2; ++b)
#pragma unroll
                for (int m = 0; m < 4; ++m)
#pragma unroll
                    for (int n = 0; n < 2; ++n) acc[a][b][m][n] = (f32x4){0.f, 0.f, 0.f, 0.f};
        if constexpr (GATHER) {
#pragma unroll
            for (int h = 0; h < 2; ++h)
#pragma unroll
                for (int i = 0; i < 2; ++i) { const int rw = h * HALF + RA[i]; int t = 0; if (rw < cur.aux1) t = gtok[cur.aux0 + rw] & 0xffff; voffA[h][i] = (unsigned)(t * K + CA[i]) * 2u; }
            VM_WAIT();
        }
        const char* cA = cur.A; const char* cB = cur.B;
        PG8_STAGE(PG8_SB(0, 0), cB, voffB); PG8_STAGE(PG8_SB(0, 1), cB + hstep, voffB); PG8_STAGE(PG8_SA(0, 0), cA, voffA[0]); PG8_STAGE(PG8_SA(0, 1), cA, voffA[1]);
        if (wr == 1) PG8_BAR;
        PG8_WAIT_V(2); PG8_BAR;
        PG8_STAGE(PG8_SB(1, 0), cB + kstep, voffB); PG8_STAGE(PG8_SA(1, 0), cA + kstep, voffA[0]); PG8_STAGE(PG8_SB(1, 1), cB + hstep + kstep, voffB);
        PG8_WAIT_V(6); PG8_BAR;
        bool more = false;
        for (;;) {
            const bool has_next = GATHER ? false : S.next(ui + 1, nxt);
            const char* nA = has_next ? nxt.A : cA; const char* nB = has_next ? nxt.B : cB;
#pragma unroll 1
            for (int t = 0; t < nt; t += 2) {
                const bool last = (t == nt - 2);
                const char* a1 = cA + (size_t)(t + 1) * kstep;
                const char* a2 = last ? nA : cA + (size_t)(t + 2) * kstep; const char* b2 = last ? nB : cB + (size_t)(t + 2) * kstep;
                const char* a3 = a2 + kstep; const char* b3 = b2 + kstep;
                PG8_LDB(B0, 0, 0); PG8_LDB(B1, 0, 1); PG8_SCHED; PG8_LDA(At, 0, 0); PG8_STAGE(PG8_SA(1, 1), a1, voffA[1]);
                PG8_WAIT_V(8); PG8_WAIT_L(0); PG8_BAR; PG8_MMA(0, 0, At, B0); PG8_MMA(0, 1, At, B1); PG8_BAR; PG8_SCHED;
                PG8_LDA(At, 0, 1); PG8_STAGE(PG8_SB(0, 0), b2, voffB); PG8_STAGE(PG8_SB(0, 1), b2 + hstep, voffB); PG8_STAGE(PG8_SA(0, 0), a2, voffA[0]);
                PG8_WAIT_V(8); PG8_WAIT_L(0); PG8_BAR; PG8_MMA(1, 0, At, B0); PG8_MMA(1, 1, At, B1); PG8_BAR; PG8_SCHED;
                PG8_LDB(B0, 1, 0); PG8_LDB(B1, 1, 1); PG8_SCHED; PG8_LDA(At, 1, 0); PG8_STAGE(PG8_SA(0, 1), a2, voffA[1]);
                PG8_WAIT_V(8); PG8_WAIT_L(0); PG8_BAR; PG8_MMA(0, 0, At, B0); PG8_MMA(0, 1, At, B1); PG8_BAR; PG8_SCHED;
                PG8_LDA(At, 1, 1); PG8_STAGE(PG8_SB(1, 0), b3, voffB); PG8_STAGE(PG8_SB(1, 1), b3 + hstep, voffB); PG8_STAGE(PG8_SA(1, 0), a3, voffA[0]);
                PG8_WAIT_V(8); PG8_WAIT_L(0); PG8_BAR; PG8_MMA(1, 0, At, B0); PG8_MMA(1, 1, At, B1); PG8_BAR; PG8_SCHED;
            }
            if (wr == 0) PG8_BAR;
            E(acc, cur, wr, wc, fr, fq);
            if (!has_next) { if constexpr (GATHER) { more = S.next(ui + 1, nxt); } break; }
#pragma unroll
            for (int a = 0; a < 2; ++a)
#pragma unroll
                for (int b = 0; b < 2; ++b)
#pragma unroll
                    for (int m = 0; m < 4; ++m)
#pragma unroll
                        for (int n = 0; n < 2; ++n) acc[a][b][m][n] = (f32x4){0.f, 0.f, 0.f, 0.f};
            cur = nxt; cA = nA; cB = nB; ++ui;
            if (wr == 1) PG8_BAR;
        }
        PG8_WAIT_V(0);
        PG8_BAR;
        if (!more) break;
        cur = nxt; ++ui;
    }
#undef PG8_SA
#undef PG8_SB
#undef PG8_STAGE
#undef PG8_LDA
#undef PG8_LDB
#undef PG8_MMA
#undef PG8_WAIT_V
#undef PG8_WAIT_L
#undef PG8_BAR
#undef PG8_SCHED
}
}

#define XB_TMO      128
#define XB_XCNT(j)  (256  + 64 * (j))
#define XB_XSUB(j)  (1280 + 64 * (j))
#define XB_XGEN(j)  (2304 + 64 * (j))
#define XB_TOP      3328
#define XB_TOPGEN   3392
#define XCD_BAR_WORDS 3456
#define XB_SPIN_CAP (1u << 18)
__device__ __forceinline__ unsigned xb_ld(unsigned* p)              { return __hip_atomic_load(p, __ATOMIC_RELAXED, __HIP_MEMORY_SCOPE_AGENT); }
__device__ __forceinline__ unsigned xb_add(unsigned* p, unsigned v) { return __hip_atomic_fetch_add(p, v, __ATOMIC_RELAXED, __HIP_MEMORY_SCOPE_AGENT); }
__device__ __forceinline__ unsigned xb_xcc_id() { return (unsigned)__builtin_amdgcn_s_getreg((3 << 11) | 20) & 0xFu; }
#define XB_SPIN(cond, bar) do { unsigned _sp = 0; while (cond) { __builtin_amdgcn_s_sleep(1); \
    if ((++_sp & 255u) == 0u) { if (xb_ld(&(bar)[XB_TMO])) break; if (_sp > XB_SPIN_CAP) { atomicAdd(&(bar)[XB_TMO], 1u); break; } } } } while (0)
struct XcdBarrier { unsigned* bar; unsigned x; volatile LAS unsigned* st; };
__device__ __forceinline__ XcdBarrier xcd_barrier_post(unsigned* bar, volatile LAS unsigned* st) {
    XcdBarrier b; b.bar = bar; b.x = xb_xcc_id(); b.st = st;
    if (threadIdx.x == 0) (void)xb_add(&bar[XB_XCNT(b.x)], 1u);
    return b;
}
__device__ __forceinline__ void xcd_barrier_complete(unsigned* bar, unsigned x, unsigned& nloc, unsigned& nx) {
    const unsigned G = gridDim.x * gridDim.y * gridDim.z;
    unsigned sum, cnt, mine, sp = 0u;
    for (;;) {
        sum = 0u; cnt = 0u; mine = 0u;
#pragma unroll
        for (unsigned j = 0; j < 16; ++j) { const unsigned c = xb_ld(&bar[XB_XCNT(j)]); sum += c; cnt += (c > 0u) ? 1u : 0u; mine = (j == x) ? c : mine; }
        if (sum == G) break;
        __builtin_amdgcn_s_sleep(1);
        if ((++sp & 255u) == 0u) { if (xb_ld(&bar[XB_TMO])) break; if (sp > XB_SPIN_CAP) { atomicAdd(&bar[XB_TMO], 1u); break; } }
    }
    nloc = mine > 0u ? mine : 1u; nx = cnt > 0u ? cnt : 1u;
}
__device__ __forceinline__ void xcd_barrier(const XcdBarrier& b) {
    asm volatile("s_waitcnt vmcnt(0)" ::: "memory");
    __syncthreads();
    if (threadIdx.x == 0) {
        unsigned* bar = b.bar;
        __builtin_amdgcn_s_waitcnt(0);
        unsigned nloc = b.st[0], nx = b.st[1];
        if (nloc == 0u) { xcd_barrier_complete(bar, b.x, nloc, nx); b.st[0] = nloc; b.st[1] = nx; }
        const unsigned old = xb_add(&bar[XB_XSUB(b.x)], 1u);
        const unsigned gen = old / nloc;
        if (old + 1u == (gen + 1u) * nloc) {
            __builtin_amdgcn_fence(__ATOMIC_RELEASE, "agent");
            asm volatile("s_waitcnt vmcnt(0)" ::: "memory");
            const unsigned og = xb_add(&bar[XB_TOP], 1u);
            const unsigned tg = og / nx;
            if (og + 1u == (tg + 1u) * nx) xb_add(&bar[XB_TOPGEN], 1u);
            else XB_SPIN(xb_ld(&bar[XB_TOPGEN]) == tg, bar);
            __builtin_amdgcn_fence(__ATOMIC_ACQUIRE, "agent");
            xb_add(&bar[XB_XGEN(b.x)], 1u);
            asm volatile("s_waitcnt vmcnt(0)" ::: "memory");
        } else {
            XB_SPIN(xb_ld(&bar[XB_XGEN(b.x)]) == gen, bar);
            __builtin_amdgcn_fence(__ATOMIC_ACQUIRE, "agent");
            asm volatile("s_waitcnt vmcnt(0)" ::: "memory");
        }
    }
    __syncthreads();
}

__device__ __forceinline__ float gelu_tanh(float v) {
    const float t = v * (-2.302208198f + (-0.1029432319f) * v * v);
    const float e = __builtin_amdgcn_exp2f(t);
    return v * __builtin_amdgcn_rcpf(1.0f + e);
}
struct EpiProj {
    static constexpr bool PERM = true;
    bf16_t* O;
    __device__ __forceinline__ void operator()(const f32x4 (&acc)[2][2][4][2], const pg8::Unit& u, int wr, int wc, int fr, int fq) const {
        const int row0 = u.pm * 256 + wr * 64 + fr, col0 = u.pn * 256 + wc * 32 + 8 * fq;
        const int kind = u.pn < 4 ? 0 : (u.pn < 12 ? 1 : 2);
#pragma unroll
        for (int ai = 0; ai < 2; ++ai)
#pragma unroll
            for (int m = 0; m < 4; ++m) { bf16_t* rowp = O + (size_t)(row0 + ai * 128 + m * 16) * INW + col0;
#pragma unroll
                for (int bj = 0; bj < 2; ++bj) { f32x4 v0 = acc[ai][bj][m][0], v1 = acc[ai][bj][m][1];
                    if (kind == 0) { v0 = v0 * QSCALE; v1 = v1 * QSCALE; }
                    else if (kind == 2) {
#pragma unroll
                        for (int j = 0; j < 4; ++j) { v0[j] = gelu_tanh(v0[j]); v1[j] = gelu_tanh(v1[j]); } }
                    u32x4 w; w.x = cvt_pk_bf16(v0[0], v0[1]); w.y = cvt_pk_bf16(v0[2], v0[3]); w.z = cvt_pk_bf16(v1[0], v1[1]); w.w = cvt_pk_bf16(v1[2], v1[3]);
                    *(u32x4*)(rowp + bj * 128) = w; } }
    }
};
struct EpiY {
    static constexpr bool PERM = false;
    const float* X; float* Y;
    __device__ __forceinline__ void operator()(const f32x4 (&acc)[2][2][4][2], const pg8::Unit& u, int wr, int wc, int fr, int fq) const {
        const int row0 = u.pm * 256 + wr * 64 + fr, col0 = u.pn * 256 + wc * 32 + 4 * fq;
#pragma unroll
        for (int ai = 0; ai < 2; ++ai)
#pragma unroll
            for (int m = 0; m < 4; ++m) { const size_t off = (size_t)(row0 + ai * 128 + m * 16) * DM + col0;
#pragma unroll
                for (int bj = 0; bj < 2; ++bj)
#pragma unroll
                    for (int n = 0; n < 2; ++n) { const f32x4 xv = *(const f32x4*)(X + off + bj * 128 + n * 16);
                        *(f32x4*)(Y + off + bj * 128 + n * 16) = xv * DN_ALPHA + acc[ai][bj][m][n]; } }
    }
};
struct EpiGU {
    static constexpr bool PERM = true;
    bf16_t* H; const float* tokw;
    __device__ __forceinline__ void operator()(const f32x4 (&acc)[2][2][4][2], const pg8::Unit& u, int wr, int wc, int fr, int fq) const {
        const int rl0 = wr * 64 + fr, col0 = u.pn * 128 + wc * 32 + 8 * fq;
#pragma unroll
        for (int ai = 0; ai < 2; ++ai)
#pragma unroll
            for (int m = 0; m < 4; ++m) { const int rl = rl0 + ai * 128 + m * 16; const float w = rl < u.aux1 ? tokw[u.aux0 + rl] : 0.f;
                const f32x4 g0 = acc[ai][0][m][0], g1 = acc[ai][0][m][1], u0 = acc[ai][1][m][0], u1 = acc[ai][1][m][1]; f32x4 h0, h1;
#pragma unroll
                for (int j = 0; j < 4; ++j) { h0[j] = g0[j] * __builtin_amdgcn_rcpf(1.0f + __builtin_amdgcn_exp2f(-LOG2E * g0[j])) * u0[j] * w;
                                              h1[j] = g1[j] * __builtin_amdgcn_rcpf(1.0f + __builtin_amdgcn_exp2f(-LOG2E * g1[j])) * u1[j] * w; }
                u32x4 o; o.x = cvt_pk_bf16(h0[0], h0[1]); o.y = cvt_pk_bf16(h0[2], h0[3]); o.z = cvt_pk_bf16(h1[0], h1[1]); o.w = cvt_pk_bf16(h1[2], h1[3]);
                *(u32x4*)(H + (size_t)(u.pm * 256 + rl) * DEXP + col0) = o; }
    }
};
struct EpiDown {
    static constexpr bool PERM = true;
    bf16_t* O; const int* tokl;
    __device__ __forceinline__ void operator()(const f32x4 (&acc)[2][2][4][2], const pg8::Unit& u, int wr, int wc, int fr, int fq) const {
        const int rl0 = wr * 64 + fr, col0 = u.pn * 256 + wc * 32 + 8 * fq;
        const __amdgpu_buffer_rsrc_t rs = __builtin_amdgcn_make_buffer_rsrc(O, 0, 2 * TOK * DM * 2, 0x00020000);
        int ent[2][4];
#pragma unroll
        for (int ai = 0; ai < 2; ++ai)
#pragma unroll
            for (int m = 0; m < 4; ++m) { const int rl = rl0 + ai * 128 + m * 16; ent[ai][m] = rl < u.aux1 ? tokl[u.aux0 + rl] : -1; }
#pragma unroll
        for (int ai = 0; ai < 2; ++ai)
#pragma unroll
            for (int m = 0; m < 4; ++m) { const int e = ent[ai][m];
                if (e >= 0) { const unsigned voff = (unsigned)((((e >> 16) * TOK + (e & 0xffff)) * DM + col0) * 2);
#pragma unroll
                    for (int bj = 0; bj < 2; ++bj) { const f32x4 v0 = acc[ai][bj][m][0], v1 = acc[ai][bj][m][1];
                        u32x4 w; w.x = cvt_pk_bf16(v0[0], v0[1]); w.y = cvt_pk_bf16(v0[2], v0[3]); w.z = cvt_pk_bf16(v1[0], v1[1]); w.w = cvt_pk_bf16(v1[2], v1[3]);
                        __builtin_amdgcn_raw_buffer_store_b128(w, rs, voff + bj * 256, 0, 0); } } }
    }
};
struct SchedMoE {
    const LAS int* tab; int ncol, G, c; const char* A; const char* B; size_t btile;
    bool gather;
    __device__ __forceinline__ bool next(int i, pg8::Unit& u) const {
        const int NT = __builtin_amdgcn_readfirstlane(tab[0]);
        const int L = i * G + c; if (L >= NT * ncol) return false;
        const int t = L / ncol, pn = L % ncol;
        const int e = __builtin_amdgcn_readfirstlane(tab[1 + 4 * t]), lt = __builtin_amdgcn_readfirstlane(tab[2 + 4 * t]), nv = __builtin_amdgcn_readfirstlane(tab[3 + 4 * t]);
        u.pm = t; u.pn = pn; u.aux0 = e * TOK + lt * 256; u.aux1 = nv;
        u.A = gather ? A : A + (size_t)t * 256 * DEXP * 2;
        u.B = B + ((size_t)e * ncol + pn) * btile;
        return true;
    }
};

__device__ __forceinline__ float wave_sum(float v) {
#pragma unroll
    for (int o = 1; o < 64; o <<= 1) v += __shfl_xor(v, o);
    return v;
}
__device__ __forceinline__ void tr_item(const float* W, int ldw, bf16_t* WT, int ldwt, LAS float* scr, int lane) {
#pragma unroll 8
    for (int i = 0; i < 32; ++i) { const int kk = 2 * i + (lane >> 5); scr[kk * 33 + (lane & 31)] = W[(size_t)kk * ldw + (lane & 31)]; }
    LDS_WAIT(); asm volatile("" ::: "memory");
    const int c = lane & 7;
#pragma unroll
    for (int j = 0; j < 4; ++j) { const int n = (lane >> 3) + 8 * j; const LAS float* s = scr + (8 * c) * 33 + n;
        u32x4 o; o.x = cvt_pk_bf16(s[0 * 33], s[1 * 33]); o.y = cvt_pk_bf16(s[2 * 33], s[3 * 33]); o.z = cvt_pk_bf16(s[4 * 33], s[5 * 33]); o.w = cvt_pk_bf16(s[6 * 33], s[7 * 33]);
        *(GAS u32x4*)(WT + (size_t)n * ldwt + 8 * c) = o; }
    LDS_WAIT(); asm volatile("" ::: "memory");
}

namespace att {
constexpr int LDP = INW;
constexpr int SHM_V = 16384, SHM_K = 16384;
constexpr int OFF_WS = 65536, OFF_TBL = 65536 + 2048;
constexpr float THR2 = 8.f * LOG2E;
#define KSWZ(row, colB) ((row) * 256 + ((colB) ^ (((row) & 7) << 4)))
#define SBAR() __builtin_amdgcn_sched_barrier(0)
__device__ __forceinline__ int crow(int r, int hi) { return (r & 3) + 8 * (r >> 2) + 4 * hi; }
__device__ __forceinline__ unsigned cvtpk(float lo, float hi) { unsigned r; asm volatile("v_cvt_pk_bf16_f32 %0, %1, %2" : "=v"(r) : "v"(lo), "v"(hi)); return r; }

__device__ __forceinline__ void partialSM(f32x16& p0, f32x16& p1, float& m_reg, float& mn, float& alpha, int dk, float c_lo, float c_hi, const float* tblp) {
    float c;
    if (dk < -153) c = c_lo; else if (dk > 121) c = c_hi;
    else { c = 0.f; const float* t = tblp + dk;
#pragma unroll
        for (int r = 0; r < 16; ++r) { p0[r] += t[(r & 3) + 8 * (r >> 2)]; p1[r] += t[32 + (r & 3) + 8 * (r >> 2)]; } }
    float pmax = p0[0];
#pragma unroll
    for (int r = 1; r < 16; ++r) pmax = fmaxf(pmax, p0[r]);
#pragma unroll
    for (int r = 0; r < 16; ++r) pmax = fmaxf(pmax, p1[r]);
    { auto rr = __builtin_amdgcn_permlane32_swap(__float_as_uint(pmax), __float_as_uint(pmax), false, false);
      pmax = fmaxf(__uint_as_float(rr[0]), __uint_as_float(rr[1])); }
    pmax += c;
    if (__builtin_expect(__all(pmax - m_reg <= THR2), 1)) { mn = m_reg; alpha = 1.f; }
    else { mn = fmaxf(m_reg, pmax); alpha = __builtin_amdgcn_exp2f(m_reg - mn); m_reg = mn; }
    const float off = c - mn;
#pragma unroll
    for (int r = 0; r < 16; ++r) p0[r] = p0[r] + off;
#pragma unroll
    for (int r = 0; r < 16; ++r) p1[r] = p1[r] + off;
#pragma unroll
    for (int r = 0; r < 16; ++r) p0[r] = __builtin_amdgcn_exp2f(p0[r]);
}
__device__ __forceinline__ void finishSM(f32x16& p0, f32x16& p1, float alpha, float& l_reg, bf16x8& pa0, bf16x8& pa1, bf16x8& pa2, bf16x8& pa3) {
#pragma unroll
    for (int r = 0; r < 16; ++r) p1[r] = __builtin_amdgcn_exp2f(p1[r]);
    float ps = 0;
#pragma unroll
    for (int r = 0; r < 16; ++r) ps += p0[r];
#pragma unroll
    for (int r = 0; r < 16; ++r) ps += p1[r];
    { auto rr = __builtin_amdgcn_permlane32_swap(__float_as_uint(ps), __float_as_uint(ps), false, false);
      ps = __uint_as_float(rr[0]) + __uint_as_float(rr[1]); }
    l_reg = l_reg * alpha + ps;
#define PK4(P, BASE, OUT) do { unsigned a0 = cvtpk(P[BASE + 0], P[BASE + 1]), a1 = cvtpk(P[BASE + 2], P[BASE + 3]);   \
    unsigned b0 = cvtpk(P[BASE + 4], P[BASE + 5]), b1 = cvtpk(P[BASE + 6], P[BASE + 7]);                              \
    auto r0 = __builtin_amdgcn_permlane32_swap(a0, b0, false, false); auto r1 = __builtin_amdgcn_permlane32_swap(a1, b1, false, false); \
    u32x4 w = {r0[0], r1[0], r0[1], r1[1]}; OUT = *reinterpret_cast<bf16x8*>(&w); } while (0)
    PK4(p0, 0, pa0); PK4(p0, 8, pa1); PK4(p1, 0, pa2); PK4(p1, 8, pa3);
#undef PK4
}
__device__ __forceinline__ void qkt(f32x16& p0, f32x16& p1, const char* Ks, const bf16x8* qr, int r32, int hi, int map) {
    p0 = f32x16{}; p1 = f32x16{};
#pragma unroll
    for (int d0 = 0; d0 < 4; ++d0) { const int cb = ((map * 4 + d0) * 16 + hi * 8) * 2;
        bf16x8 b0 = *reinterpret_cast<const bf16x8*>(Ks + KSWZ(r32, cb));
        bf16x8 b1 = *reinterpret_cast<const bf16x8*>(Ks + KSWZ(32 + r32, cb));
        p0 = __builtin_amdgcn_mfma_f32_32x32x16_bf16(b0, qr[d0], p0, 0, 0, 0);
        p1 = __builtin_amdgcn_mfma_f32_32x32x16_bf16(b1, qr[d0], p1, 0, 0, 0); }
}
__device__ __forceinline__ int v_st(int k, int c) { const int kk = (k & ~0xC) | ((k & 4) << 1) | ((k & 8) >> 1); return ((kk >> 3) * 4 + (c >> 5)) * 512 + ((kk & 7) * 32 + (c & 31)) * 2; }
__device__ __forceinline__ int v_rd_base(int lane) { return ((lane & 3) << 3) | (((lane >> 2) & 3) << 6) | (((lane >> 4) & 1) << 5) | (((lane >> 5) & 1) << 8); }
constexpr int v_rd_off(int d0, int ks, int half) { return d0 * 512 + ks * 4096 + half * 2048; }
template <int OFF> __device__ __forceinline__ s16x4 tr_read(int vb) {
    s16x4 r; asm volatile("ds_read_b64_tr_b16 %0, %1 offset:%2" : "=&v"(r) : "v"(vb), "i"(OFF) : "memory"); return r;
}
template <int D0> __device__ __forceinline__ void pv_one(f32x16& od, int vb, bf16x8 pa0, bf16x8 pa1, bf16x8 pa2, bf16x8 pa3) {
    const s16x4 l0 = tr_read<v_rd_off(D0, 0, 0)>(vb), h0 = tr_read<v_rd_off(D0, 0, 1)>(vb), l1 = tr_read<v_rd_off(D0, 1, 0)>(vb), h1 = tr_read<v_rd_off(D0, 1, 1)>(vb);
    const s16x4 l2 = tr_read<v_rd_off(D0, 2, 0)>(vb), h2 = tr_read<v_rd_off(D0, 2, 1)>(vb), l3 = tr_read<v_rd_off(D0, 3, 0)>(vb), h3 = tr_read<v_rd_off(D0, 3, 1)>(vb);
    asm volatile("s_waitcnt lgkmcnt(0)" ::: "memory"); SBAR();
#define PK(L, H) (bf16x8){L[0], L[1], L[2], L[3], H[0], H[1], H[2], H[3]}
    od = __builtin_amdgcn_mfma_f32_32x32x16_bf16(pa0, PK(l0, h0), od, 0, 0, 0);
    od = __builtin_amdgcn_mfma_f32_32x32x16_bf16(pa1, PK(l1, h1), od, 0, 0, 0);
    od = __builtin_amdgcn_mfma_f32_32x32x16_bf16(pa2, PK(l2, h2), od, 0, 0, 0);
    od = __builtin_amdgcn_mfma_f32_32x32x16_bf16(pa3, PK(l3, h3), od, 0, 0, 0);
#undef PK
}
__device__ __forceinline__ void pv_d0(f32x16* o, int vb, bf16x8 pa0, bf16x8 pa1, bf16x8 pa2, bf16x8 pa3) {
    pv_one<0>(o[0], vb, pa0, pa1, pa2, pa3); pv_one<1>(o[1], vb, pa0, pa1, pa2, pa3); pv_one<2>(o[2], vb, pa0, pa1, pa2, pa3); pv_one<3>(o[3], vb, pa0, pa1, pa2, pa3);
}
__device__ __forceinline__ int t5_bucket(int rel) {
    const int n = rel < 0 ? -rel : rel; int b;
    if (n < 8) b = n; else if (n < 12) b = 8; else if (n < 16) b = 9; else if (n < 23) b = 10; else if (n < 32) b = 11; else if (n < 46) b = 12; else if (n < 64) b = 13; else if (n < 91) b = 14; else b = 15;
    return b + (rel > 0 ? 16 : 0);
}
__device__ __forceinline__ void attn_unit(int b, int h, int qb, const bf16_t* __restrict__ P, bf16_t* __restrict__ mix, const float* __restrict__ relb, const float* __restrict__ subg, float lam, char* lds) {
    const int tid = threadIdx.x, wid = tid >> 6, lane = tid & 63, r32 = lane & 31, hi = lane >> 5, map = wid >> 2, wq = wid & 3;
    char* V_lds = lds; char* K_lds = lds + 2 * SHM_V;
    float* ws = (float*)(lds + OFF_WS) + wid * 64; float* li_l = ws; float* al_l = ws + 32;
    float* tbl = (float*)(lds + OFF_TBL);
    __syncthreads();
    for (int i = tid; i < 513; i += 512) tbl[i] = relb[t5_bucket(i - 256) * NH + h] * LOG2E;
    const float c_lo = relb[15 * NH + h] * LOG2E, c_hi = relb[31 * NH + h] * LOG2E;
    const int qpos0 = qb * 128 + wq * 32;
    const float* tblp = tbl + 256 - r32 + 4 * hi;
    float m_reg = -1e30f, l_reg = 0; f32x16 o[4] = {}; bf16x8 qr[4];
    const bf16_t* Qw = P + (size_t)(b * SEQ + qpos0 + r32) * LDP + Q_OFF + h * 128 + map * 64 + hi * 8;
#pragma unroll
    for (int d0 = 0; d0 < 4; ++d0) qr[d0] = *reinterpret_cast<const bf16x8*>(Qw + d0 * 16);
    const bf16_t* Kh = P + (size_t)(b * SEQ) * LDP + K_OFF + h * 128;
    const bf16_t* Vh = P + (size_t)(b * SEQ) * LDP + V_OFF + h * 128;
    const int sr = tid >> 4, sc = (tid & 15) * 8, vst0 = v_st(sr, sc), vst1 = v_st(32 + sr, sc);
    const int vb0 = (int)(uintptr_t)V_lds + v_rd_base(lane);
    struct { bf16x8 vs0, vs1, ks0, ks1; } sr_[2];
#define SLOAD(i, k0) do { sr_[i].vs0 = *reinterpret_cast<const bf16x8*>(&Vh[(size_t)((k0) + sr) * LDP + sc]); sr_[i].vs1 = *reinterpret_cast<const bf16x8*>(&Vh[(size_t)((k0) + 32 + sr) * LDP + sc]); \
    sr_[i].ks0 = *reinterpret_cast<const bf16x8*>(&Kh[(size_t)((k0) + sr) * LDP + sc]); sr_[i].ks1 = *reinterpret_cast<const bf16x8*>(&Kh[(size_t)((k0) + 32 + sr) * LDP + sc]); } while (0)
#define SWRITE(bq, i) do { *(bf16x8*)(V_lds + (bq) * SHM_V + vst0) = sr_[i].vs0;          \
    *(bf16x8*)(V_lds + (bq) * SHM_V + vst1) = sr_[i].vs1; int kc = sc * 2;               \
    *(bf16x8*)(K_lds + (bq) * SHM_K + KSWZ(sr, kc)) = sr_[i].ks0;                       \
    *(bf16x8*)(K_lds + (bq) * SHM_K + KSWZ(32 + sr, kc)) = sr_[i].ks1; } while (0)
#define SWAIT() asm volatile("s_waitcnt vmcnt(4)" ::: "memory")
#define RESC(a) do { if (__any((a) < 1.f)) { if (hi == 0) al_l[r32] = (a); asm volatile("s_waitcnt lgkmcnt(0)" ::: "memory"); \
    _Pragma("unroll") for (int d = 0; d < 4; ++d) _Pragma("unroll") for (int r = 0; r < 16; ++r) o[d][r] *= al_l[crow(r, hi)]; } } while (0)
    f32x16 pA0, pA1, pB0, pB1; float mnA, mnB, alA, alB; bf16x8 pa0, pa1, pa2, pa3; constexpr int NT = SEQ / 64;
    constexpr int SE = 0, SO = 1;
    SLOAD(SE, 0); asm volatile("s_waitcnt vmcnt(0)" ::: "memory"); SWRITE(0, SE); __syncthreads();
    qkt(pA0, pA1, K_lds, qr, r32, hi, map); partialSM(pA0, pA1, m_reg, mnA, alA, 0 - qpos0, c_lo, c_hi, tblp);
    SLOAD(SO, 64); SLOAD(SE, 128);
    SWAIT(); SWRITE(1, SO); __syncthreads();
    for (int j = 1; j + 1 < NT; j += 2) {
        SBAR(); qkt(pB0, pB1, K_lds + SHM_K, qr, r32, hi, map);
        finishSM(pA0, pA1, alA, l_reg, pa0, pa1, pa2, pa3); SBAR();
        SLOAD(SO, (j + 2) * 64); SBAR();
        pv_d0(o, vb0, pa0, pa1, pa2, pa3); partialSM(pB0, pB1, m_reg, mnB, alB, j * 64 - qpos0, c_lo, c_hi, tblp);
        __syncthreads(); SWAIT(); SWRITE(0, SE);
        RESC(alB); __syncthreads();
        SBAR(); qkt(pA0, pA1, K_lds, qr, r32, hi, map);
        finishSM(pB0, pB1, alB, l_reg, pa0, pa1, pa2, pa3); SBAR();
        if (j + 3 < NT) SLOAD(SE, (j + 3) * 64); SBAR();
        pv_d0(o, vb0 + SHM_V, pa0, pa1, pa2, pa3); partialSM(pA0, pA1, m_reg, mnA, alA, (j + 1) * 64 - qpos0, c_lo, c_hi, tblp);
        __syncthreads(); SWAIT(); SWRITE(1, SO);
        RESC(alA); __syncthreads();
    }
    SBAR(); qkt(pB0, pB1, K_lds + SHM_K, qr, r32, hi, map);
    finishSM(pA0, pA1, alA, l_reg, pa0, pa1, pa2, pa3); SBAR();
    pv_d0(o, vb0, pa0, pa1, pa2, pa3); partialSM(pB0, pB1, m_reg, mnB, alB, (NT - 1) * 64 - qpos0, c_lo, c_hi, tblp);
    __syncthreads(); RESC(alB);
    finishSM(pB0, pB1, alB, l_reg, pa0, pa1, pa2, pa3); SBAR();
    pv_d0(o, vb0 + SHM_V, pa0, pa1, pa2, pa3);
    if (hi == 0) li_l[r32] = l_reg; asm volatile("s_waitcnt lgkmcnt(0)" ::: "memory");
    float rli[16];
#pragma unroll
    for (int r = 0; r < 16; ++r) rli[r] = __builtin_amdgcn_rcpf(li_l[crow(r, hi)]);
    __syncthreads();
    float* X = (float*)lds;
    if (map == 1) {
#pragma unroll
        for (int d0 = 0; d0 < 4; ++d0)
#pragma unroll
            for (int r = 0; r < 16; ++r) X[(d0 * 16 + r) * 256 + wq * 64 + lane] = o[d0][r] * rli[r];
    }
    __syncthreads();
    if (map == 0) {
        float sg[4];
#pragma unroll
        for (int d0 = 0; d0 < 4; ++d0) sg[d0] = subg[d0 * 32 + r32] * SUBLN_MUL;
        bf16_t* Ob = mix + (size_t)(b * SEQ + qpos0) * DM + h * 128 + r32;
#pragma unroll
        for (int r = 0; r < 16; ++r) {
            float v[4]; float ss = 0.f;
#pragma unroll
            for (int d0 = 0; d0 < 4; ++d0) { v[d0] = o[d0][r] * rli[r] - lam * X[(d0 * 16 + r) * 256 + wq * 64 + lane]; ss += v[d0] * v[d0]; }
#pragma unroll
            for (int s = 1; s < 32; s <<= 1) ss += __shfl_xor(ss, s);
            const float rms = __builtin_amdgcn_rsqf(ss * (1.0f / 128.0f) + LN_EPS);
            const int orow = crow(r, hi);
#pragma unroll
            for (int d0 = 0; d0 < 4; ++d0) Ob[(size_t)orow * DM + d0 * 32] = (bf16_t)(cvtpk(v[d0] * rms * sg[d0], 0.f) & 0xffffu);
        }
    }
#undef SLOAD
#undef SWRITE
#undef SWAIT
#undef RESC
}

__device__ __forceinline__ void sg_unit(int b, int c, int g, const bf16_t* __restrict__ P, bf16_t* __restrict__ mix, const float* __restrict__ lng, const float* __restrict__ lnb,
                                        const bf16_t* __restrict__ sgw, const float* __restrict__ sgb, char* lds) {
    int tid = threadIdx.x; asm volatile("" : "+v"(tid));
    const int wid = tid >> 6, lane = tid & 63, r32 = lane & 31, hi = lane >> 5;
    const size_t row0 = (size_t)b * SEQ + (size_t)c * 128;
    const int sr = tid >> 4, sc = (tid & 15) * 8;
    __syncthreads();
    {
        const f32x4 g0 = *(const f32x4*)(lng + g * 128 + sc), g1 = *(const f32x4*)(lng + g * 128 + sc + 4), b0 = *(const f32x4*)(lnb + g * 128 + sc), b1 = *(const f32x4*)(lnb + g * 128 + sc + 4);
        u32x4 w[4];
#pragma unroll
        for (int i = 0; i < 4; ++i) w[i] = *reinterpret_cast<const u32x4*>(P + (row0 + sr + 32 * i) * LDP + G_OFF + g * 128 + sc);
#pragma unroll
        for (int i = 0; i < 4; ++i) {
            float v[8] = {bflo(w[i].x), bfhi(w[i].x), bflo(w[i].y), bfhi(w[i].y), bflo(w[i].z), bfhi(w[i].z), bflo(w[i].w), bfhi(w[i].w)};
            float s = ((v[0] + v[1]) + (v[2] + v[3])) + ((v[4] + v[5]) + (v[6] + v[7]));
            s += __shfl_xor(s, 1); s += __shfl_xor(s, 2); s += __shfl_xor(s, 4); s += __shfl_xor(s, 8);
            const float mean = s * (1.0f / 128.0f); float s2 = 0.f;
#pragma unroll
            for (int j = 0; j < 8; ++j) { v[j] -= mean; s2 += v[j] * v[j]; }
            s2 += __shfl_xor(s2, 1); s2 += __shfl_xor(s2, 2); s2 += __shfl_xor(s2, 4); s2 += __shfl_xor(s2, 8);
            const float rstd = __builtin_amdgcn_rsqf(s2 * (1.0f / 128.0f) + LN_EPS);
            u32x4 o; o.x = cvtpk(v[0] * rstd * g0[0] + b0[0], v[1] * rstd * g0[1] + b0[1]); o.y = cvtpk(v[2] * rstd * g0[2] + b0[2], v[3] * rstd * g0[3] + b0[3]);
            o.z = cvtpk(v[4] * rstd * g1[0] + b1[0], v[5] * rstd * g1[1] + b1[1]); o.w = cvtpk(v[6] * rstd * g1[2] + b1[2], v[7] * rstd * g1[3] + b1[3]);
            const int q = sr + 32 * i;
            *(u32x4*)(lds + (q >> 6) * 16384 + v_st(q & 63, sc)) = o;
        }
    }
    __syncthreads();
    const int pblk = wid >> 1, dbase = (wid & 1) * 2;
    f32x16 acc0 = {}, acc1 = {};
    const bf16_t* Wp = sgw + ((size_t)g * 128 + pblk * 32 + r32) * 128 + hi * 8;
    const int vb = (int)(uintptr_t)lds + v_rd_base(lane);
#define SGPK(L, H) (bf16x8){L[0], L[1], L[2], L[3], H[0], H[1], H[2], H[3]}
#define SG_STEP(T, KS) do { \
        const bf16x8 a_ = *reinterpret_cast<const bf16x8*>(Wp + ((T) * 4 + (KS)) * 16); \
        const s16x4 l0 = tr_read<(T) * 16384 + v_rd_off(0, KS, 0)>(vb + dbase * 512), h0 = tr_read<(T) * 16384 + v_rd_off(0, KS, 1)>(vb + dbase * 512); \
        const s16x4 l1 = tr_read<(T) * 16384 + v_rd_off(1, KS, 0)>(vb + dbase * 512), h1 = tr_read<(T) * 16384 + v_rd_off(1, KS, 1)>(vb + dbase * 512); \
        asm volatile("s_waitcnt lgkmcnt(0)" ::: "memory"); SBAR(); \
        acc0 = __builtin_amdgcn_mfma_f32_32x32x16_bf16(a_, SGPK(l0, h0), acc0, 0, 0, 0); \
        acc1 = __builtin_amdgcn_mfma_f32_32x32x16_bf16(a_, SGPK(l1, h1), acc1, 0, 0, 0); } while (0)
    SG_STEP(0, 0); SG_STEP(0, 1); SG_STEP(0, 2); SG_STEP(0, 3); SG_STEP(1, 0); SG_STEP(1, 1); SG_STEP(1, 2); SG_STEP(1, 3);
#undef SG_STEP
#undef SGPK
    float* M = (float*)(lds + 32768);
#pragma unroll
    for (int r = 0; r < 16; ++r) { const int p = pblk * 32 + crow(r, hi); const float bs = sgb[g * 128 + p];
        M[p * 132 + dbase * 32 + r32] = acc0[r] + bs; M[p * 132 + dbase * 32 + 32 + r32] = acc1[r] + bs; }
    __syncthreads();
#pragma unroll
    for (int i = 0; i < 4; ++i) { const int p = sr + 32 * i;
        const u32x4 uw = *reinterpret_cast<const u32x4*>(P + (row0 + p) * LDP + U_OFF + g * 128 + sc);
        const f32x4 m0 = *(const f32x4*)(M + p * 132 + sc), m1 = *(const f32x4*)(M + p * 132 + sc + 4);
        u32x4 o; o.x = cvtpk(bflo(uw.x) * m0[0], bfhi(uw.x) * m0[1]); o.y = cvtpk(bflo(uw.y) * m0[2], bfhi(uw.y) * m0[3]);
        o.z = cvtpk(bflo(uw.z) * m1[0], bfhi(uw.z) * m1[1]); o.w = cvtpk(bflo(uw.w) * m1[2], bfhi(uw.w) * m1[3]);
        *(u32x4*)(mix + (row0 + p) * DM + 1024 + g * 128 + sc) = o; }
}
#undef KSWZ
#undef SBAR
}

constexpr int NWAVES = 8;
constexpr int N_PHASES = 8;
struct Args { const float* in[24]; float* out; unsigned char* ws; int ph_lo, ph_hi; };
static_assert(sizeof(Args) == 24 * 8 + 8 + 8 + 8, "Args has no padding");

__global__ void __launch_bounds__(NWAVES * 64, 2) mega(Args args) {
    extern __shared__ __attribute__((aligned(16))) unsigned char lds[];
    LAS unsigned char* L = (LAS unsigned char*)lds;
    volatile LAS unsigned* MISC = (volatile LAS unsigned*)(L + MISC_OFF);
    const int tid = threadIdx.x, lane = tid & 63, wave = __builtin_amdgcn_readfirstlane(tid >> 6);
    const int G = gridDim.x; const int bx = blockIdx.x; const int vcu = (G % 8 == 0) ? (bx % 8) * (G / 8) + bx / 8 : bx;
    unsigned char* ws = args.ws;
    GAS unsigned* ctl = (GAS unsigned*)(ws + WS_CTL);
    const float* x = args.in[0]; const float* w_in = args.in[1]; const float* w_out = args.in[2];
    const float* ln1g = args.in[3]; const float* ln1b = args.in[4]; const float* ln2g = args.in[5]; const float* ln2b = args.in[6];
    const float* relb = args.in[7]; const float* lq1 = args.in[8]; const float* lk1 = args.in[9]; const float* lq2 = args.in[10]; const float* lk2 = args.in[11];
    const float* subg = args.in[12]; const float* sglng = args.in[13]; const float* sglnb = args.in[14]; const float* sgw = args.in[15]; const float* sgb = args.in[16];
    const float* wrg = args.in[17]; const float* brg = args.in[18]; const float* wre = args.in[19]; const float* bre = args.in[20];
    const float* wg = args.in[21]; const float* wu = args.in[22]; const float* wd = args.in[23];
    float* out = args.out;
    bf16_t* WinT = (bf16_t*)(ws + WS_WIN); bf16_t* WoutT = (bf16_t*)(ws + WS_WOUT); bf16_t* WguT = (bf16_t*)(ws + WS_WGU); bf16_t* WdT = (bf16_t*)(ws + WS_WD);
    bf16_t* sgwb = (bf16_t*)(ws + WS_SGW); bf16_t* xb = (bf16_t*)(ws + WS_XB); bf16_t* Pb = (bf16_t*)(ws + WS_P); bf16_t* mix = (bf16_t*)(ws + WS_MIX);
    float* Y = (float*)(ws + WS_Y); float* H1 = (float*)(ws + WS_H1); bf16_t* H1B = (bf16_t*)(ws + WS_H1B); bf16_t* HB = (bf16_t*)(ws + WS_HB); bf16_t* OB = (bf16_t*)(ws + WS_O);
    int* tokl = (int*)(ws + WS_TOKL); float* tokw = (float*)(ws + WS_TOKW);
    bf16_t* WRH = (bf16_t*)(ws + WS_WRH); bf16_t* WRL = (bf16_t*)(ws + WS_WRL);

    for (int u = tid; u < (LDS_BYTES - MISC_OFF) / 4; u += NWAVES * 64) ((LAS unsigned*)(L + MISC_OFF))[u] = 0u;
    __syncthreads();
    XcdBarrier bar; bar.bar = (unsigned*)(ws + WS_CTL) + CW_BAR; bar.x = 0; bar.st = nullptr;
    if (MK_N_LAUNCHES == 1) bar = xcd_barrier_post((unsigned*)(ws + WS_CTL) + CW_BAR, MISC + 8);
    const int lo = args.ph_lo, hi_ = args.ph_hi;
#ifndef PHASE_MASK
#define PHASE_MASK 0xff
#endif
#define IN(k) (((PHASE_MASK >> (k)) & 1) && lo <= (k) && (k) < hi_)
#define GRID_BAR(k) do { if (IN(k) && IN((k) + 1)) xcd_barrier(bar); } while (0)
    const int gw = vcu * NWAVES + wave, NGW = G * NWAVES;

    if (IN(0)) {
        LAS float* scr = (LAS float*)(L + wave * 16384);
        constexpr int I_IN = 32 * 160, I_OUT = 32 * 64, I_D = 32 * 256;
        constexpr int NITEMS = I_IN + I_OUT + I_D;
        for (int it = gw; it < NITEMS; it += NGW) {
            int r = it;
            if (r < I_IN) { const int kb = r / 160, nb = r % 160; tr_item(w_in + (size_t)kb * 64 * INW + nb * 32, INW, WinT + (size_t)nb * 32 * DM + kb * 64, DM, scr, lane); continue; } r -= I_IN;
            if (r < I_OUT) { const int kb = r / 64, nb = r % 64; tr_item(w_out + (size_t)kb * 64 * DM + nb * 32, DM, WoutT + (size_t)nb * 32 * DM + kb * 64, DM, scr, lane); continue; } r -= I_OUT;
            { const int e = r / 256, q = r % 256, kb = q / 64, nb = q % 64;
              tr_item(wd + (size_t)e * DEXP * DM + (size_t)kb * 64 * DM + nb * 32, DM, WdT + ((size_t)e * DM + nb * 32) * DEXP + kb * 64, DEXP, scr, lane); }
        }
        const size_t gt = (size_t)vcu * (NWAVES * 64) + tid, NGT = (size_t)G * NWAVES * 64;
        for (size_t i = gt; i < (size_t)TOK * DM / 8; i += NGT) { const f32x4 a = *(const f32x4*)(x + i * 8), b = *(const f32x4*)(x + i * 8 + 4);
            u32x4 w; w.x = cvt_pk_bf16(a[0], a[1]); w.y = cvt_pk_bf16(a[2], a[3]); w.z = cvt_pk_bf16(b[0], b[1]); w.w = cvt_pk_bf16(b[2], b[3]); *(u32x4*)(xb + i * 8) = w; }
        for (size_t i = gt; i < (size_t)48 * DM; i += NGT) { const int n = (int)(i / DM), k = (int)(i % DM);
            float w = 0.f; if (n < 4) w = wrg[(size_t)k * 4 + n]; else if (n < 36) { const int g2 = (n - 4) >> 3, i2 = (n - 4) & 7; w = wre[((size_t)g2 * DM + k) * EPG + i2]; }
            const unsigned hb = cvt_pk_bf16(w, 0.f) & 0xffffu; const float lo = w - __uint_as_float(hb << 16);
            WRH[i] = (bf16_t)hb; WRL[i] = (bf16_t)(cvt_pk_bf16(lo, 0.f) & 0xffffu); }
        for (size_t i = gt; i < (size_t)8 * 128 * 128 / 8; i += NGT) { const f32x4 a = *(const f32x4*)(sgw + i * 8), b = *(const f32x4*)(sgw + i * 8 + 4);
            u32x4 w; w.x = cvt_pk_bf16(a[0], a[1]); w.y = cvt_pk_bf16(a[2], a[3]); w.z = cvt_pk_bf16(b[0], b[1]); w.w = cvt_pk_bf16(b[2], b[3]); *(u32x4*)(sgwb + i * 8) = w; }
    }
    GRID_BAR(0);

    if (IN(1)) {
        pg8::SchedDense S; S.init(TOK, INW, DM, G, bx, xb, WinT);
        EpiProj E{Pb};
        pg8::gemm_phase<EpiProj, pg8::SchedDense, false>(L, DM, S, E, nullptr);
        constexpr int NU = (TOK / 256) * (INW / 256); const int rem = NU % G; const int nshort = G - rem;
        if (bx >= rem) {
            LAS float* scr = (LAS float*)(L + wave * 16384);
            constexpr int I_G = 32 * 256;
            for (int it = (bx - rem) * NWAVES + wave; it < 2 * I_G; it += nshort * NWAVES) {
                int r = it; const bool up = r >= I_G; if (up) r -= I_G; const int e = r / 256, q = r % 256, kb = q / 8, nb = q % 8;
                const float* src = (up ? wu : wg) + (size_t)e * DM * DEXP + (size_t)kb * 64 * DEXP + nb * 32;
                const int drow = e * 512 + (nb >> 2) * 256 + (up ? 128 : 0) + (nb & 3) * 32;
                tr_item(src, DEXP, WguT + (size_t)drow * DM + kb * 64, DM, scr, lane); }
        }
    }
    GRID_BAR(1);

    if (IN(2)) {
        float lam;
        { const float a = lane < 64 ? lq1[lane] * lk1[lane] : 0.f, c = lq2[lane] * lk2[lane];
          lam = __expf(wave_sum(a)) - __expf(wave_sum(c)) + LAM_INIT; }
        for (int u = vcu; u < 512; u += G) { const int bh = u >> 5, qb = u & 31; att::attn_unit(bh >> 3, bh & 7, qb, Pb, mix, relb, subg, lam, (char*)lds); }
        for (int u = vcu; u < 512; u += G) { const int g = u & 7, c = (u >> 3) & 31, b = u >> 8; att::sg_unit(b, c, g, Pb, mix, sglng, sglnb, sgwb, sgb, (char*)lds); }
        __syncthreads();
    }
    GRID_BAR(2);

    if (IN(3)) {
        pg8::SchedDense S; S.init(TOK, DM, DM, G, bx, mix, WoutT);
        EpiY E{x, Y};
        pg8::gemm_phase<EpiY, pg8::SchedDense, false>(L, DM, S, E, nullptr);
    }
    GRID_BAR(3);

    if (IN(4)) {
        constexpr int HSTR = 4112;
        LAS unsigned char* Hhi = L; LAS unsigned char* Hlo = L + 16 * HSTR;
        LAS float* part = (LAS float*)L;
        LAS float* lgt = (LAS float*)(L + 8 * 16 * 48 * 4);
        for (int t0 = vcu * 16; t0 < TOK; t0 += G * 16) {
            __syncthreads();
#pragma unroll
            for (int tt = 0; tt < 2; ++tt) {
                const int row = wave * 2 + tt, t = t0 + row;
                const f32x4* yr = (const f32x4*)(Y + (size_t)t * DM) + lane;
                f32x4 v[8]; float s = 0.f;
#pragma unroll
                for (int j = 0; j < 8; ++j) { v[j] = yr[64 * j]; s += (v[j][0] + v[j][1]) + (v[j][2] + v[j][3]); }
                const float mean = wave_sum(s) * (1.0f / DM); float s2 = 0.f;
#pragma unroll
                for (int j = 0; j < 8; ++j) { v[j] = v[j] - mean; s2 += (v[j][0] * v[j][0] + v[j][1] * v[j][1]) + (v[j][2] * v[j][2] + v[j][3] * v[j][3]); }
                const float rstd = 1.0f / sqrtf(wave_sum(s2) * (1.0f / DM) + LN_EPS);
#pragma unroll
                for (int j = 0; j < 8; ++j) { const int col = 256 * j + 4 * lane; const f32x4 gg = *(const f32x4*)(ln1g + col), bb = *(const f32x4*)(ln1b + col);
                    v[j] = v[j] * rstd * gg + bb;
                    *(f32x4*)(H1 + (size_t)t * DM + col) = v[j];
                    u32x2 w; w.x = cvt_pk_bf16(v[j][0], v[j][1]); w.y = cvt_pk_bf16(v[j][2], v[j][3]); *(u32x2*)(H1B + (size_t)t * DM + col) = w;
                    u32x2 wl; wl.x = cvt_pk_bf16(v[j][0] - bflo(w.x), v[j][1] - bfhi(w.x)); wl.y = cvt_pk_bf16(v[j][2] - bflo(w.y), v[j][3] - bfhi(w.y));
                    *(LAS u32x2*)(Hhi + row * HSTR + col * 2) = w; *(LAS u32x2*)(Hlo + row * HSTR + col * 2) = wl; }
            }
            __syncthreads();
            f32x4 acc[3] = {{0.f, 0.f, 0.f, 0.f}, {0.f, 0.f, 0.f, 0.f}, {0.f, 0.f, 0.f, 0.f}};
            { const int ar = lane & 15, kc = lane >> 4;
#pragma unroll
              for (int sidx = 0; sidx < 8; ++sidx) { const int k = 256 * wave + 32 * sidx + 8 * kc;
                  const bf16x8 ah = *(const LAS bf16x8*)(Hhi + ar * HSTR + k * 2), al = *(const LAS bf16x8*)(Hlo + ar * HSTR + k * 2);
#pragma unroll
                  for (int nt = 0; nt < 3; ++nt) { const bf16x8 bh = *(const bf16x8*)(WRH + (size_t)(nt * 16 + ar) * DM + k), bl = *(const bf16x8*)(WRL + (size_t)(nt * 16 + ar) * DM + k);
                      acc[nt] = __builtin_amdgcn_mfma_f32_16x16x32_bf16(ah, bh, acc[nt], 0, 0, 0);
                      acc[nt] = __builtin_amdgcn_mfma_f32_16x16x32_bf16(al, bh, acc[nt], 0, 0, 0);
                      acc[nt] = __builtin_amdgcn_mfma_f32_16x16x32_bf16(ah, bl, acc[nt], 0, 0, 0); } } }
            __syncthreads();
#pragma unroll
            for (int nt = 0; nt < 3; ++nt)
#pragma unroll
                for (int r = 0; r < 4; ++r) part[(wave * 16 + (lane >> 4) * 4 + r) * 48 + nt * 16 + (lane & 15)] = acc[nt][r];
            __syncthreads();
            for (int i = tid; i < 16 * 48; i += NWAVES * 64) { float a = 0.f;
#pragma unroll
                for (int w = 0; w < 8; ++w) a += part[w * 768 + i];
                lgt[i] = a; }
            __syncthreads();
            if (tid < 16) {
                const int t = t0 + tid; const LAS float* lp = lgt + tid * 48;
                float lg[4];
#pragma unroll
                for (int q = 0; q < 4; ++q) lg[q] = lp[q] + brg[q];
                int gi = 0; float gm = lg[0];
#pragma unroll
                for (int q = 1; q < 4; ++q) if (lg[q] > gm) { gm = lg[q]; gi = q; }
                float gs = 0.f;
#pragma unroll
                for (int q = 0; q < 4; ++q) gs += __expf(lg[q] - gm);
                const float ggate = 1.0f / gs;
                float el[8];
#pragma unroll
                for (int q = 0; q < 8; ++q) el[q] = lp[4 + gi * 8 + q] + bre[gi * EPG + q];
                int i1 = 0; float v1 = el[0];
#pragma unroll
                for (int q = 1; q < 8; ++q) if (el[q] > v1) { v1 = el[q]; i1 = q; }
                int i2 = -1; float v2 = -3.0e38f;
#pragma unroll
                for (int q = 0; q < 8; ++q) if (q != i1 && el[q] > v2) { v2 = el[q]; i2 = q; }
                const float e2 = __expf(v2 - v1); const float w1 = ggate / (1.0f + e2), w2 = ggate * e2 / (1.0f + e2);
                const int ex1 = gi * EPG + i1, ex2 = gi * EPG + i2;
                const unsigned p1 = __hip_atomic_fetch_add(ctl + CW_CNT + ex1, 1u, RLX_AGENT);
                const unsigned p2 = __hip_atomic_fetch_add(ctl + CW_CNT + ex2, 1u, RLX_AGENT);
                tokl[ex1 * TOK + p1] = t; tokw[ex1 * TOK + p1] = w1;
                tokl[ex2 * TOK + p2] = t | (1 << 16); tokw[ex2 * TOK + p2] = w2;
            }
        }
        __syncthreads();
    }
    GRID_BAR(4);

    LAS int* tab = (LAS int*)(L + LDSX_OFF);
    if (IN(5) || IN(6)) {
        __syncthreads();
        if (tid < 32) {
            const int c = (int)__hip_atomic_load(ctl + CW_CNT + tid, RLX_AGENT); const int n = (c + 255) >> 8;
            int incl = n;
#pragma unroll
            for (int o = 1; o < 32; o <<= 1) { const int v = __shfl_up(incl, o); if (tid >= o) incl += v; }
            int t = incl - n;
            for (int l = 0; l < n; ++l, ++t) { tab[1 + 4 * t] = tid; tab[2 + 4 * t] = l; tab[3 + 4 * t] = (c - l * 256) < 256 ? (c - l * 256) : 256; tab[4 + 4 * t] = 0; }
            if (tid == 31) tab[0] = incl;
        }
        __syncthreads();
    }
    if (IN(5)) {
        SchedMoE S{tab, 2, G, bx, (const char*)H1B, (const char*)WguT, (size_t)256 * DM * 2, true};
        EpiGU E{HB, tokw};
        pg8::gemm_phase<EpiGU, SchedMoE, true>(L, DM, S, E, tokl);
    }
    GRID_BAR(5);
    if (IN(6)) {
        SchedMoE S{tab, 8, G, bx, (const char*)HB, (const char*)WdT, (size_t)256 * DEXP * 2, false};
        EpiDown E{OB, tokl};
        pg8::gemm_phase<EpiDown, SchedMoE, false>(L, DEXP, S, E, nullptr);
    }
    GRID_BAR(6);

    if (IN(7)) {
        for (int t = gw; t < TOK; t += NGW) {
            f32x4 v[8]; float s = 0.f;
#pragma unroll
            for (int j = 0; j < 8; ++j) { const int col = 256 * j + 4 * lane; const f32x4 h = *(const f32x4*)(H1 + (size_t)t * DM + col);
                const u32x2 a = *(const u32x2*)(OB + (size_t)t * DM + col), b = *(const u32x2*)(OB + ((size_t)TOK + t) * DM + col);
                v[j][0] = h[0] * DN_ALPHA + (bflo(a.x) + bflo(b.x)); v[j][1] = h[1] * DN_ALPHA + (bfhi(a.x) + bfhi(b.x));
                v[j][2] = h[2] * DN_ALPHA + (bflo(a.y) + bflo(b.y)); v[j][3] = h[3] * DN_ALPHA + (bfhi(a.y) + bfhi(b.y));
                s += (v[j][0] + v[j][1]) + (v[j][2] + v[j][3]); }
            const float mean = wave_sum(s) * (1.0f / DM); float s2 = 0.f;
#pragma unroll
            for (int j = 0; j < 8; ++j) { v[j] = v[j] - mean; s2 += (v[j][0] * v[j][0] + v[j][1] * v[j][1]) + (v[j][2] * v[j][2] + v[j][3] * v[j][3]); }
            const float rstd = 1.0f / sqrtf(wave_sum(s2) * (1.0f / DM) + LN_EPS);
#pragma unroll
            for (int j = 0; j < 8; ++j) { const int col = 256 * j + 4 * lane; const f32x4 gg = *(const f32x4*)(ln2g + col), bb = *(const f32x4*)(ln2b + col);
                *(f32x4*)(out + (size_t)t * DM + col) = v[j] * rstd * gg + bb; }
        }
    }
#undef IN
#undef GRID_BAR
}

extern "C" void kernel_launch(void* const* d_in, const int* in_sizes, int n_in, void* d_out, int out_size, void* d_ws, size_t ws_size, hipStream_t stream) {
    static int grid = 0;
    if (grid == 0) {
        if (n_in != 24 || out_size != TOK * DM || ws_size < WS_END) { fprintf(stderr, "kernel_launch: unexpected shapes (n_in %d out %d ws %zu)\n", n_in, out_size, ws_size); grid = -1; return; }
        int dev = 0, cus = 0, per_cu = 0;
        if (hipGetDevice(&dev) != hipSuccess || hipDeviceGetAttribute(&cus, hipDeviceAttributeMultiprocessorCount, dev) != hipSuccess) { grid = -1; return; }
        if (hipFuncSetAttribute((const void*)mega, hipFuncAttributeMaxDynamicSharedMemorySize, LDS_BYTES) != hipSuccess) { fprintf(stderr, "kernel_launch: hipFuncSetAttribute failed\n"); grid = -1; return; }
        if (hipOccupancyMaxActiveBlocksPerMultiprocessor(&per_cu, (const void*)mega, NWAVES * 64, LDS_BYTES) != hipSuccess || per_cu < 1)
            fprintf(stderr, "kernel_launch: occupancy query reports %d workgroups per CU\n", per_cu);
        (void)hipGetLastError();
        grid = cus;
    }
    if (grid < 0) return;
    if (hipMemsetAsync((char*)d_ws + WS_CTL, 0, CTL_ZERO_BYTES, stream) != hipSuccess) return;
    Args a{};
    for (int i = 0; i < 24; ++i) a.in[i] = (const float*)d_in[i];
    a.out = (float*)d_out; a.ws = (unsigned char*)d_ws;
    if (MK_N_LAUNCHES == 1) { a.ph_lo = 0; a.ph_hi = N_PHASES; hipLaunchKernelGGL(mega, dim3(grid), dim3(NWAVES * 64), LDS_BYTES, stream, a); }
    else {
#ifndef PROBE_REP
#define PROBE_REP 1,1,1,1,1,1,1,1
#endif
        const int reps[N_PHASES] = {PROBE_REP};
        for (int p = 0; p < N_PHASES; ++p) for (int r = 0; r < reps[p]; ++r) {
            if (p == 4 && r > 0) (void)hipMemsetAsync((char*)d_ws + WS_CTL, 0, CTL_ZERO_BYTES, stream);
            a.ph_lo = p; a.ph_hi = p + 1; hipLaunchKernelGGL(mega, dim3(grid), dim3(NWAVES * 64), LDS_BYTES, stream, a); }
    }
}
```

```cpp
#include <hip/hip_runtime.h>
#include <cstdio>
#include <cstdint>

#ifndef MK_N_LAUNCHES
#define MK_N_LAUNCHES 1
#endif

#define GAS __attribute__((address_space(1)))
#define LAS __attribute__((address_space(3)))
typedef unsigned short bf16_t;
typedef short bf16x8 __attribute__((ext_vector_type(8)));
typedef short s16x4 __attribute__((ext_vector_type(4)));
typedef float f32x2 __attribute__((ext_vector_type(2)));
typedef float f32x4 __attribute__((ext_vector_type(4)));
typedef float f32x16 __attribute__((ext_vector_type(16)));
typedef unsigned u32x2 __attribute__((ext_vector_type(2)));
typedef unsigned u32x4 __attribute__((ext_vector_type(4)));

constexpr int TOK = 8192, SEQ = 4096, DM = 2048, INW = 5120, NH = 8;
constexpr int NEXP = 32, DEXP = 256, EPG = 8;
constexpr int Q_OFF = 0, K_OFF = 1024, V_OFF = 2048, U_OFF = 3072, G_OFF = 4096;
constexpr float DN_ALPHA = 1.189207115002721f;
constexpr float LN_EPS = 1e-5f;
constexpr float LOG2E = 1.4426950408889634f;
constexpr float QSCALE = 0.125f * LOG2E;
constexpr float SUBLN_MUL = 0.8f;
constexpr float LAM_INIT = 0.2f;

constexpr size_t MiB = 1u << 20;
constexpr size_t WS_CTL = 0, CTL_ZERO_BYTES = 1 * MiB;
constexpr size_t WS_TOKL = 1 * MiB, WS_TOKW = 2 * MiB;
constexpr size_t WS_SGW = 3 * MiB;
constexpr size_t WS_WRH = 3 * MiB + 512 * 1024, WS_WRL = 3 * MiB + 768 * 1024;
constexpr size_t WS_WGU = 4 * MiB;
constexpr size_t WS_WD = 68 * MiB;
constexpr size_t WS_WIN = 100 * MiB;
constexpr size_t WS_WOUT = 120 * MiB;
constexpr size_t WS_XB = 128 * MiB;
constexpr size_t WS_MIX = 160 * MiB;
constexpr size_t WS_P = 192 * MiB;
constexpr size_t WS_H1 = 100 * MiB;
constexpr size_t WS_H1B = 164 * MiB;
constexpr size_t WS_HB = 196 * MiB;
constexpr size_t WS_Y = 208 * MiB;
constexpr size_t WS_O = 208 * MiB;
constexpr size_t WS_END = 272 * MiB;
constexpr int CW_CNT = 1024;
constexpr int CW_BAR = 4096;

constexpr int RING_BYTES = 131072;
constexpr int LDSX_OFF = RING_BYTES;
constexpr int MISC_OFF = RING_BYTES + 8192;
constexpr int LDS_BYTES = 147456;

#define RLX_AGENT __ATOMIC_RELAXED, __HIP_MEMORY_SCOPE_AGENT
#define LDS_WAIT() asm volatile("s_waitcnt lgkmcnt(0)" ::: "memory")
#define VM_WAIT() asm volatile("s_waitcnt vmcnt(0)" ::: "memory")

__device__ __forceinline__ unsigned cvt_pk_bf16(float lo, float hi) { unsigned r; asm volatile("v_cvt_pk_bf16_f32 %0, %1, %2" : "=v"(r) : "v"(lo), "v"(hi)); return r; }
__device__ __forceinline__ float bf2f(unsigned short b) { return __uint_as_float(((unsigned)b) << 16); }
__device__ __forceinline__ float bflo(unsigned w) { return __uint_as_float(w << 16); }
__device__ __forceinline__ float bfhi(unsigned w) { return __uint_as_float(w & 0xffff0000u); }

namespace pg8 {
constexpr int BM = 256, BK = 64, HALF = 128, HTB = HALF * BK * 2, NXCD = 8, WGM = 8;
__host__ __device__ __forceinline__ int lds_byte(int r, int c) { const int st = (r >> 4) * 2 + (c >> 5), rr = r & 15, cc = c & 31, ob = rr * 64 + cc * 2; return st * 1024 + (ob ^ (((ob >> 9) & 1) << 5)); }
__host__ __device__ __forceinline__ void stage_rc(int b, int& R, int& C) { const int st = b / 1024, sb = b % 1024, swz = sb ^ (((sb >> 9) & 1) << 5); R = (st >> 1) * 16 + swz / 64; C = (st & 1) * 32 + (swz % 64) / 2; }
__host__ __device__ __forceinline__ int perm32(int rho) { const int n = rho >> 4, i = rho & 15; return 8 * (i >> 2) + 4 * n + (i & 3); }

struct Unit { int pm, pn; const char* A; const char* B; int aux0, aux1; };

struct SchedDense {
    int nM, nN, nwg, G, c; const char* A; const char* B; size_t ta, tb;
    __device__ __forceinline__ void init(int M, int N, int K, int G_, int c_, const void* A_, const void* B_) { nM = M / BM; nN = N / BM; nwg = nM * nN; G = G_; c = c_; A = (const char*)A_; B = (const char*)B_; ta = (size_t)BM * K * 2; tb = ta; }
    __device__ __forceinline__ bool next(int i, Unit& u) const {
        const long L = (long)i * G + c; if (L >= nwg) return false;
        int wgid = (int)L; { const int q = nwg / NXCD, r = nwg % NXCD, xcd = wgid % NXCD, off = wgid / NXCD; wgid = (xcd < r ? xcd * (q + 1) : r * (q + 1) + (xcd - r) * q) + off; }
        const int nig = WGM * nN, gid = wgid / nig, fm = gid * WGM, gsz = (nM - fm) < WGM ? (nM - fm) : WGM;
        u.pm = fm + ((wgid % nig) % gsz); u.pn = (wgid % nig) / gsz; u.A = A + (size_t)u.pm * ta; u.B = B + (size_t)u.pn * tb; u.aux0 = 0; u.aux1 = 0; return true;
    }
};

template <class Epi, class Sched, bool GATHER>
__device__ __forceinline__ void gemm_phase(LAS unsigned char* lds, const int K, const Sched& S, const Epi& E, const int* gtok  ) {
    const int tid = threadIdx.x, wid = __builtin_amdgcn_readfirstlane(tid >> 6), lane = tid & 63, wr = wid >> 2, wc = wid & 3, fr = lane & 15, fq = lane >> 4;
    const int nt = K / BK;
    unsigned voffA[2][2], voffB[2]; int RA[2], CA[2];
#pragma unroll
    for (int i = 0; i < 2; ++i) { int R, C; stage_rc(tid * 16 + i * 8192, R, C); const int Rb = Epi::PERM ? ((R & ~31) + perm32(R & 31)) : R;
        RA[i] = R; CA[i] = C;
        voffA[0][i] = (unsigned)(R * K + C) * 2u; voffA[1][i] = (unsigned)((R + HALF) * K + C) * 2u; voffB[i] = (unsigned)(Rb * K + C) * 2u; }
    const size_t kstep = (size_t)(BK * 2);
    const size_t hstep = (size_t)HALF * K * 2;
    const unsigned ldsw = (unsigned)wid * 1024u;
    const int aoff = lds_byte(wr * 64 + fr, fq * 8), boff = lds_byte(wc * 32 + fr, fq * 8);
#define PG8_SA(b, h) (((b) * 2 + (h)) * HTB)
#define PG8_SB(b, h) ((4 + (b) * 2 + (h)) * HTB)
#define PG8_STAGE(bufoff, gbase, voff) do { _Pragma("unroll") for (int _i = 0; _i < 2; ++_i) \
        __builtin_amdgcn_global_load_lds((const unsigned*)((const char*)(gbase) + (voff)[_i]), (LAS unsigned*)(lds + (bufoff) + ldsw + _i * 8192), 16, 0, 0); } while (0)
#define PG8_LDA(dst, b, h) do { _Pragma("unroll") for (int m = 0; m < 4; ++m) _Pragma("unroll") for (int k = 0; k < 2; ++k) dst[m][k] = *(const LAS bf16x8*)(lds + PG8_SA(b, h) + aoff + m * 2048 + k * 1024); } while (0)
#define PG8_LDB(dst, b, h) do { _Pragma("unroll") for (int n = 0; n < 2; ++n) _Pragma("unroll") for (int k = 0; k < 2; ++k) dst[n][k] = *(const LAS bf16x8*)(lds + PG8_SB(b, h) + boff + n * 2048 + k * 1024); } while (0)
#define PG8_MMA(ai, bj, At, Bt) do { __builtin_amdgcn_s_setprio(1); _Pragma("unroll") for (int m = 0; m < 4; ++m) _Pragma("unroll") for (int n = 0; n < 2; ++n) _Pragma("unroll") for (int k = 0; k < 2; ++k) \
        acc[ai][bj][m][n] = __builtin_amdgcn_mfma_f32_16x16x32_bf16(Bt[n][k], At[m][k], acc[ai][bj][m][n], 0, 0, 0); __builtin_amdgcn_s_setprio(0); } while (0)
#define PG8_WAIT_V(n) asm volatile("s_waitcnt vmcnt(" #n ")" ::: "memory")
#define PG8_WAIT_L(n) asm volatile("s_waitcnt lgkmcnt(" #n ")" ::: "memory")
#define PG8_BAR __builtin_amdgcn_s_barrier()
#define PG8_SCHED __builtin_amdgcn_sched_barrier(0)
    Unit cur, nxt; int ui = 0;
    if (!S.next(0, cur)) return;
    f32x4 acc[2][2][4][2];
    bf16x8 At[4][2], B0[2][2], B1[2][2];
    for (;;) {
#pragma unroll
        for (int a = 0; a < 2; ++a)
#pragma unroll
            for (int b = 0; b < 2; ++b)
#pragma unroll
                for (int m = 0; m < 4; ++m)
#pragma unroll
                    for (int n = 0; n < 2; ++n) acc[a][b][m][n] = (f32x4){0.f, 0.f, 0.f, 0.f};
        if constexpr (GATHER) {
#pragma unroll
            for (int h = 0; h < 2; ++h)
#pragma unroll
                for (int i = 0; i < 2; ++i) { const int rw = h * HALF + RA[i]; int t = 0; if (rw < cur.aux1) t = gtok[cur.aux0 + rw] & 0xffff; voffA[h][i] = (unsigned)(t * K + CA[i]) * 2u; }
            VM_WAIT();
        }
        const char* cA = cur.A; const char* cB = cur.B;
        PG8_STAGE(PG8_SB(0, 0), cB, voffB); PG8_STAGE(PG8_SB(0, 1), cB + hstep, voffB); PG8_STAGE(PG8_SA(0, 0), cA, voffA[0]); PG8_STAGE(PG8_SA(0, 1), cA, voffA[1]);
        if (wr == 1) PG8_BAR;
        PG8_WAIT_V(2); PG8_BAR;
        PG8_STAGE(PG8_SB(1, 0), cB + kstep, voffB); PG8_STAGE(PG8_SA(1, 0), cA + kstep, voffA[0]); PG8_STAGE(PG8_SB(1, 1), cB + hstep + kstep, voffB);
        PG8_WAIT_V(6); PG8_BAR;
        bool more = false;
        for (;;) {
            const bool has_next = GATHER ? false : S.next(ui + 1, nxt);
            const char* nA = has_next ? nxt.A : cA; const char* nB = has_next ? nxt.B : cB;
#pragma unroll 1
            for (int t = 0; t < nt; t += 2) {
                const bool last = (t == nt - 2);
                const char* a1 = cA + (size_t)(t + 1) * kstep;
                const char* a2 = last ? nA : cA + (size_t)(t + 2) * kstep; const char* b2 = last ? nB : cB + (size_t)(t + 2) * kstep;
                const char* a3 = a2 + kstep; const char* b3 = b2 + kstep;
                PG8_LDB(B0, 0, 0); PG8_LDB(B1, 0, 1); PG8_SCHED; PG8_LDA(At, 0, 0); PG8_STAGE(PG8_SA(1, 1), a1, voffA[1]);
                PG8_WAIT_V(8); PG8_WAIT_L(0); PG8_BAR; PG8_MMA(0, 0, At, B0); PG8_MMA(0, 1, At, B1); PG8_BAR; PG8_SCHED;
                PG8_LDA(At, 0, 1); PG8_STAGE(PG8_SB(0, 0), b2, voffB); PG8_STAGE(PG8_SB(0, 1), b2 + hstep, voffB); PG8_STAGE(PG8_SA(0, 0), a2, voffA[0]);
                PG8_WAIT_V(8); PG8_WAIT_L(0); PG8_BAR; PG8_MMA(1, 0, At, B0); PG8_MMA(1, 1, At, B1); PG8_BAR; PG8_SCHED;
                PG8_LDB(B0, 1, 0); PG8_LDB(B1, 1, 1); PG8_SCHED; PG8_LDA(At, 1, 0); PG8_STAGE(PG8_SA(0, 1), a2, voffA[1]);
                PG8_WAIT_V(8); PG8_WAIT_L(0); PG8_BAR; PG8_MMA(0, 0, At, B0); PG8_MMA(0, 1, At, B1); PG8_BAR; PG8_SCHED;
                PG8_LDA(At, 1, 1); PG8_STAGE(PG8_SB(1, 0), b3, voffB); PG8_STAGE(PG8_SB(1, 1), b3 + hstep, voffB); PG8_STAGE(PG8_SA(1, 0), a3, voffA[0]);
                PG8_WAIT_V(8); PG8_WAIT_L(0); PG8_BAR; PG8_MMA(1, 0, At, B0); PG8_MMA(1, 1, At, B1); PG8_BAR; PG8_SCHED;
            }
            if (wr == 0) PG8_BAR;
            E(acc, cur, wr, wc, fr, fq);
            if (!has_next) { if constexpr (GATHER) { more = S.next(ui + 1, nxt); } break; }
#pragma unroll
            for (int a = 0; a < 2; ++a)
#pragma unroll
                for (int b = 0; b < 2; ++b)
#pragma unroll
                    for (int m = 0; m < 4; ++m)
#pragma unroll
                        for (int n = 0; n < 2; ++n) acc[a][b][m][n] = (f32x4){0.f, 0.f, 0.f, 0.f};
            cur = nxt; cA = nA; cB = nB; ++ui;
            if (wr == 1) PG8_BAR;
        }
        PG8_WAIT_V(0);
        PG8_BAR;
        if (!more) break;
        cur = nxt; ++ui;
    }
#undef PG8_SA
#undef PG8_SB
#undef PG8_STAGE
#undef PG8_LDA
#undef PG8_LDB
#undef PG8_MMA
#undef PG8_WAIT_V
#undef PG8_WAIT_L
#undef PG8_BAR
#undef PG8_SCHED
}
}

#define XB_TMO      128
#define XB_XCNT(j)  (256  + 64 * (j))
#define XB_XSUB(j)  (1280 + 64 * (j))
#define XB_XGEN(j)  (2304 + 64 * (j))
#define XB_TOP      3328
#define XB_TOPGEN   3392
#define XCD_BAR_WORDS 3456
#define XB_SPIN_CAP (1u << 18)
__device__ __forceinline__ unsigned xb_ld(unsigned* p)              { return __hip_atomic_load(p, __ATOMIC_RELAXED, __HIP_MEMORY_SCOPE_AGENT); }
__device__ __forceinline__ unsigned xb_add(unsigned* p, unsigned v) { return __hip_atomic_fetch_add(p, v, __ATOMIC_RELAXED, __HIP_MEMORY_SCOPE_AGENT); }
__device__ __forceinline__ unsigned xb_xcc_id() { return (unsigned)__builtin_amdgcn_s_getreg((3 << 11) | 20) & 0xFu; }
#define XB_SPIN(cond, bar) do { unsigned _sp = 0; while (cond) { __builtin_amdgcn_s_sleep(1); \
    if ((++_sp & 255u) == 0u) { if (xb_ld(&(bar)[XB_TMO])) break; if (_sp > XB_SPIN_CAP) { atomicAdd(&(bar)[XB_TMO], 1u); break; } } } } while (0)
struct XcdBarrier { unsigned* bar; unsigned x; volatile LAS unsigned* st; };
__device__ __forceinline__ XcdBarrier xcd_barrier_post(unsigned* bar, volatile LAS unsigned* st) {
    XcdBarrier b; b.bar = bar; b.x = xb_xcc_id(); b.st = st;
    if (threadIdx.x == 0) (void)xb_add(&bar[XB_XCNT(b.x)], 1u);
    return b;
}
__device__ __forceinline__ void xcd_barrier_complete(unsigned* bar, unsigned x, unsigned& nloc, unsigned& nx) {
    const unsigned G = gridDim.x * gridDim.y * gridDim.z;
    unsigned sum, cnt, mine, sp = 0u;
    for (;;) {
        sum = 0u; cnt = 0u; mine = 0u;
#pragma unroll
        for (unsigned j = 0; j < 16; ++j) { const unsigned c = xb_ld(&bar[XB_XCNT(j)]); sum += c; cnt += (c > 0u) ? 1u : 0u; mine = (j == x) ? c : mine; }
        if (sum == G) break;
        __builtin_amdgcn_s_sleep(1);
        if ((++sp & 255u) == 0u) { if (xb_ld(&bar[XB_TMO])) break; if (sp > XB_SPIN_CAP) { atomicAdd(&bar[XB_TMO], 1u); break; } }
    }
    nloc = mine > 0u ? mine : 1u; nx = cnt > 0u ? cnt : 1u;
}
__device__ __forceinline__ void xcd_barrier(const XcdBarrier& b) {
    asm volatile("s_waitcnt vmcnt(0)" ::: "memory");
    __syncthreads();
    if (threadIdx.x == 0) {
        unsigned* bar = b.bar;
        __builtin_amdgcn_s_waitcnt(0);
        unsigned nloc = b.st[0], nx = b.st[1];
        if (nloc == 0u) { xcd_barrier_complete(bar, b.x, nloc, nx); b.st[0] = nloc; b.st[1] = nx; }
        const unsigned old = xb_add(&bar[XB_XSUB(b.x)], 1u);
        const unsigned gen = old / nloc;
        if (old + 1u == (gen + 1u) * nloc) {
            __builtin_amdgcn_fence(__ATOMIC_RELEASE, "agent");
            asm volatile("s_waitcnt vmcnt(0)" ::: "memory");
            const unsigned og = xb_add(&bar[XB_TOP], 1u);
            const unsigned tg = og / nx;
            if (og + 1u == (tg + 1u) * nx) xb_add(&bar[XB_TOPGEN], 1u);
            else XB_SPIN(xb_ld(&bar[XB_TOPGEN]) == tg, bar);
            __builtin_amdgcn_fence(__ATOMIC_ACQUIRE, "agent");
            xb_add(&bar[XB_XGEN(b.x)], 1u);
            asm volatile("s_waitcnt vmcnt(0)" ::: "memory");
        } else {
            XB_SPIN(xb_ld(&bar[XB_XGEN(b.x)]) == gen, bar);
            __builtin_amdgcn_fence(__ATOMIC_ACQUIRE, "agent");
            asm volatile("s_waitcnt vmcnt(0)" ::: "memory");
        }
    }
    __syncthreads();
}

__device__ __forceinline__ float gelu_tanh(float v) {
    const float t = v * (-2.302208198f + (-0.1029432319f) * v * v);
    const float e = __builtin_amdgcn_exp2f(t);
    return v * __builtin_amdgcn_rcpf(1.0f + e);
}
struct EpiProj {
    static constexpr bool PERM = true;
    bf16_t* O;
    __device__ __forceinline__ void operator()(const f32x4 (&acc)[2][2][4][2], const pg8::Unit& u, int wr, int wc, int fr, int fq) const {
        const int row0 = u.pm * 256 + wr * 64 + fr, col0 = u.pn * 256 + wc * 32 + 8 * fq;
        const int kind = u.pn < 4 ? 0 : (u.pn < 12 ? 1 : 2);
#pragma unroll
        for (int ai = 0; ai < 2; ++ai)
#pragma unroll
            for (int m = 0; m < 4; ++m) { bf16_t* rowp = O + (size_t)(row0 + ai * 128 + m * 16) * INW + col0;
#pragma unroll
                for (int bj = 0; bj < 2; ++bj) { f32x4 v0 = acc[ai][bj][m][0], v1 = acc[ai][bj][m][1];
                    if (kind == 0) { v0 = v0 * QSCALE; v1 = v1 * QSCALE; }
                    else if (kind == 2) {
#pragma unroll
                        for (int j = 0; j < 4; ++j) { v0[j] = gelu_tanh(v0[j]); v1[j] = gelu_tanh(v1[j]); } }
                    u32x4 w; w.x = cvt_pk_bf16(v0[0], v0[1]); w.y = cvt_pk_bf16(v0[2], v0[3]); w.z = cvt_pk_bf16(v1[0], v1[1]); w.w = cvt_pk_bf16(v1[2], v1[3]);
                    *(u32x4*)(rowp + bj * 128) = w; } }
    }
};
struct EpiY {
    static constexpr bool PERM = false;
    const float* X; float* Y;
    __device__ __forceinline__ void operator()(const f32x4 (&acc)[2][2][4][2], const pg8::Unit& u, int wr, int wc, int fr, int fq) const {
        const int row0 = u.pm * 256 + wr * 64 + fr, col0 = u.pn * 256 + wc * 32 + 4 * fq;
#pragma unroll
        for (int ai = 0; ai < 2; ++ai)
#pragma unroll
            for (int m = 0; m < 4; ++m) { const size_t off = (size_t)(row0 + ai * 128 + m * 16) * DM + col0;
#pragma unroll
                for (int bj = 0; bj < 2; ++bj)
#pragma unroll
                    for (int n = 0; n < 2; ++n) { const f32x4 xv = *(const f32x4*)(X + off + bj * 128 + n * 16);
                        *(f32x4*)(Y + off + bj * 128 + n * 16) = xv * DN_ALPHA + acc[ai][bj][m][n]; } }
    }
};
struct EpiGU {
    static constexpr bool PERM = true;
    bf16_t* H; const float* tokw;
    __device__ __forceinline__ void operator()(const f32x4 (&acc)[2][2][4][2], const pg8::Unit& u, int wr, int wc, int fr, int fq) const {
        const int rl0 = wr * 64 + fr, col0 = u.pn * 128 + wc * 32 + 8 * fq;
#pragma unroll
        for (int ai = 0; ai < 2; ++ai)
#pragma unroll
            for (int m = 0; m < 4; ++m) { const int rl = rl0 + ai * 128 + m * 16; const float w = rl < u.aux1 ? tokw[u.aux0 + rl] : 0.f;
                const f32x4 g0 = acc[ai][0][m][0], g1 = acc[ai][0][m][1], u0 = acc[ai][1][m][0], u1 = acc[ai][1][m][1]; f32x4 h0, h1;
#pragma unroll
                for (int j = 0; j < 4; ++j) { h0[j] = g0[j] * __builtin_amdgcn_rcpf(1.0f + __builtin_amdgcn_exp2f(-LOG2E * g0[j])) * u0[j] * w;
                                              h1[j] = g1[j] * __builtin_amdgcn_rcpf(1.0f + __builtin_amdgcn_exp2f(-LOG2E * g1[j])) * u1[j] * w; }
                u32x4 o; o.x = cvt_pk_bf16(h0[0], h0[1]); o.y = cvt_pk_bf16(h0[2], h0[3]); o.z = cvt_pk_bf16(h1[0], h1[1]); o.w = cvt_pk_bf16(h1[2], h1[3]);
                *(u32x4*)(H + (size_t)(u.pm * 256 + rl) * DEXP + col0) = o; }
    }
};
struct EpiDown {
    static constexpr bool PERM = true;
    bf16_t* O; const int* tokl;
    __device__ __forceinline__ void operator()(const f32x4 (&acc)[2][2][4][2], const pg8::Unit& u, int wr, int wc, int fr, int fq) const {
        const int rl0 = wr * 64 + fr, col0 = u.pn * 256 + wc * 32 + 8 * fq;
        const __amdgpu_buffer_rsrc_t rs = __builtin_amdgcn_make_buffer_rsrc(O, 0, 2 * TOK * DM * 2, 0x00020000);
        int ent[2][4];
#pragma unroll
        for (int ai = 0; ai < 2; ++ai)
#pragma unroll
            for (int m = 0; m < 4; ++m) { const int rl = rl0 + ai * 128 + m * 16; ent[ai][m] = rl < u.aux1 ? tokl[u.aux0 + rl] : -1; }
#pragma unroll
        for (int ai = 0; ai < 2; ++ai)
#pragma unroll
            for (int m = 0; m < 4; ++m) { const int e = ent[ai][m];
                if (e >= 0) { const unsigned voff = (unsigned)((((e >> 16) * TOK + (e & 0xffff)) * DM + col0) * 2);
#pragma unroll
                    for (int bj = 0; bj < 2; ++bj) { const f32x4 v0 = acc[ai][bj][m][0], v1 = acc[ai][bj][m][1];
                        u32x4 w; w.x = cvt_pk_bf16(v0[0], v0[1]); w.y = cvt_pk_bf16(v0[2], v0[3]); w.z = cvt_pk_bf16(v1[0], v1[1]); w.w = cvt_pk_bf16(v1[2], v1[3]);
                        __builtin_amdgcn_raw_buffer_store_b128(w, rs, voff + bj * 256, 0, 0); } } }
    }
};
struct SchedMoE {
    const LAS int* tab; int ncol, G, c; const char* A; const char* B; size_t btile;
    bool gather;
    __device__ __forceinline__ bool next(int i, pg8::Unit& u) const {
        const int NT = __builtin_amdgcn_readfirstlane(tab[0]);
        const int L = i * G + c; if (L >= NT * ncol) return false;
        const int t = L / ncol, pn = L % ncol;
        const int e = __builtin_amdgcn_readfirstlane(tab[1 + 4 * t]), lt = __builtin_amdgcn_readfirstlane(tab[2 + 4 * t]), nv = __builtin_amdgcn_readfirstlane(tab[3 + 4 * t]);
        u.pm = t; u.pn = pn; u.aux0 = e * TOK + lt * 256; u.aux1 = nv;
        u.A = gather ? A : A + (size_t)t * 256 * DEXP * 2;
        u.B = B + ((size_t)e * ncol + pn) * btile;
        return true;
    }
};

__device__ __forceinline__ float wave_sum(float v) {
#pragma unroll
    for (int o = 1; o < 64; o <<= 1) v += __shfl_xor(v, o);
    return v;
}
__device__ __forceinline__ void tr_item(const float* W, int ldw, bf16_t* WT, int ldwt, LAS float* scr, int lane) {
    float v[32];
#pragma unroll
    for (int i = 0; i < 32; ++i) v[i] = W[(size_t)(2 * i + (lane >> 5)) * ldw + (lane & 31)];
#pragma unroll
    for (int i = 0; i < 32; ++i) scr[(2 * i + (lane >> 5)) * 33 + (lane & 31)] = v[i];
    LDS_WAIT(); asm volatile("" ::: "memory");
    const int c = lane & 7;
#pragma unroll
    for (int j = 0; j < 4; ++j) { const int n = (lane >> 3) + 8 * j; const LAS float* s = scr + (8 * c) * 33 + n;
        u32x4 o; o.x = cvt_pk_bf16(s[0 * 33], s[1 * 33]); o.y = cvt_pk_bf16(s[2 * 33], s[3 * 33]); o.z = cvt_pk_bf16(s[4 * 33], s[5 * 33]); o.w = cvt_pk_bf16(s[6 * 33], s[7 * 33]);
        *(GAS u32x4*)(WT + (size_t)n * ldwt + 8 * c) = o; }
    LDS_WAIT(); asm volatile("" ::: "memory");
}

namespace att {
constexpr int LDP = INW;
constexpr int SHM_V = 16384, SHM_K = 16384;
constexpr int OFF_WS = 65536, OFF_TBL = 65536 + 2048;
constexpr float THR2 = 8.f * LOG2E;
#define KSWZ(row, colB) ((row) * 256 + ((colB) ^ (((row) & 7) << 4)))
#define SBAR() __builtin_amdgcn_sched_barrier(0)
__device__ __forceinline__ int crow(int r, int hi) { return (r & 3) + 8 * (r >> 2) + 4 * hi; }
__device__ __forceinline__ unsigned cvtpk(float lo, float hi) { unsigned r; asm volatile("v_cvt_pk_bf16_f32 %0, %1, %2" : "=v"(r) : "v"(lo), "v"(hi)); return r; }

__device__ __forceinline__ void partialSM(f32x16& p0, f32x16& p1, float& m_reg, float& mn, float& alpha, int dk, float c_lo, float c_hi, const float* tblp) {
    float c;
    if (dk < -153) c = c_lo; else if (dk > 121) c = c_hi;
    else { c = 0.f; const float* t = tblp + dk;
#pragma unroll
        for (int r = 0; r < 16; ++r) { p0[r] += t[(r & 3) + 8 * (r >> 2)]; p1[r] += t[32 + (r & 3) + 8 * (r >> 2)]; } }
    float pmax = p0[0];
#pragma unroll
    for (int r = 1; r < 16; ++r) pmax = fmaxf(pmax, p0[r]);
#pragma unroll
    for (int r = 0; r < 16; ++r) pmax = fmaxf(pmax, p1[r]);
    { auto rr = __builtin_amdgcn_permlane32_swap(__float_as_uint(pmax), __float_as_uint(pmax), false, false);
      pmax = fmaxf(__uint_as_float(rr[0]), __uint_as_float(rr[1])); }
    pmax += c;
    if (__builtin_expect(__all(pmax - m_reg <= THR2), 1)) { mn = m_reg; alpha = 1.f; }
    else { mn = fmaxf(m_reg, pmax); alpha = __builtin_amdgcn_exp2f(m_reg - mn); m_reg = mn; }
    const float off = c - mn;
#pragma unroll
    for (int r = 0; r < 16; ++r) p0[r] = p0[r] + off;
#pragma unroll
    for (int r = 0; r < 16; ++r) p1[r] = p1[r] + off;
#pragma unroll
    for (int r = 0; r < 16; ++r) p0[r] = __builtin_amdgcn_exp2f(p0[r]);
}
__device__ __forceinline__ void finishSM(f32x16& p0, f32x16& p1, float alpha, float& l_reg, bf16x8& pa0, bf16x8& pa1, bf16x8& pa2, bf16x8& pa3) {
#pragma unroll
    for (int r = 0; r < 16; ++r) p1[r] = __builtin_amdgcn_exp2f(p1[r]);
    float ps = 0;
#pragma unroll
    for (int r = 0; r < 16; ++r) ps += p0[r];
#pragma unroll
    for (int r = 0; r < 16; ++r) ps += p1[r];
    { auto rr = __builtin_amdgcn_permlane32_swap(__float_as_uint(ps), __float_as_uint(ps), false, false);
      ps = __uint_as_float(rr[0]) + __uint_as_float(rr[1]); }
    l_reg = l_reg * alpha + ps;
#define PK4(P, BASE, OUT) do { unsigned a0 = cvtpk(P[BASE + 0], P[BASE + 1]), a1 = cvtpk(P[BASE + 2], P[BASE + 3]);   \
    unsigned b0 = cvtpk(P[BASE + 4], P[BASE + 5]), b1 = cvtpk(P[BASE + 6], P[BASE + 7]);                              \
    auto r0 = __builtin_amdgcn_permlane32_swap(a0, b0, false, false); auto r1 = __builtin_amdgcn_permlane32_swap(a1, b1, false, false); \
    u32x4 w = {r0[0], r1[0], r0[1], r1[1]}; OUT = *reinterpret_cast<bf16x8*>(&w); } while (0)
    PK4(p0, 0, pa0); PK4(p0, 8, pa1); PK4(p1, 0, pa2); PK4(p1, 8, pa3);
#undef PK4
}
__device__ __forceinline__ void qkt(f32x16& p0, f32x16& p1, const char* Ks, const bf16x8* qr, int r32, int hi, int map) {
    p0 = f32x16{}; p1 = f32x16{};
#pragma unroll
    for (int d0 = 0; d0 < 4; ++d0) { const int cb = ((map * 4 + d0) * 16 + hi * 8) * 2;
        bf16x8 b0 = *reinterpret_cast<const bf16x8*>(Ks + KSWZ(r32, cb));
        bf16x8 b1 = *reinterpret_cast<const bf16x8*>(Ks + KSWZ(32 + r32, cb));
        p0 = __builtin_amdgcn_mfma_f32_32x32x16_bf16(b0, qr[d0], p0, 0, 0, 0);
        p1 = __builtin_amdgcn_mfma_f32_32x32x16_bf16(b1, qr[d0], p1, 0, 0, 0); }
}
__device__ __forceinline__ int v_st(int k, int c) { const int kk = (k & ~0xC) | ((k & 4) << 1) | ((k & 8) >> 1); return ((kk >> 3) * 4 + (c >> 5)) * 512 + ((kk & 7) * 32 + (c & 31)) * 2; }
__device__ __forceinline__ int v_rd_base(int lane) { return ((lane & 3) << 3) | (((lane >> 2) & 3) << 6) | (((lane >> 4) & 1) << 5) | (((lane >> 5) & 1) << 8); }
constexpr int v_rd_off(int d0, int ks, int half) { return d0 * 512 + ks * 4096 + half * 2048; }
template <int OFF> __device__ __forceinline__ s16x4 tr_read(int vb) {
    s16x4 r; asm volatile("ds_read_b64_tr_b16 %0, %1 offset:%2" : "=&v"(r) : "v"(vb), "i"(OFF) : "memory"); return r;
}
template <int D0> __device__ __forceinline__ void pv_one(f32x16& od, int vb, bf16x8 pa0, bf16x8 pa1, bf16x8 pa2, bf16x8 pa3) {
    const s16x4 l0 = tr_read<v_rd_off(D0, 0, 0)>(vb), h0 = tr_read<v_rd_off(D0, 0, 1)>(vb), l1 = tr_read<v_rd_off(D0, 1, 0)>(vb), h1 = tr_read<v_rd_off(D0, 1, 1)>(vb);
    const s16x4 l2 = tr_read<v_rd_off(D0, 2, 0)>(vb), h2 = tr_read<v_rd_off(D0, 2, 1)>(vb), l3 = tr_read<v_rd_off(D0, 3, 0)>(vb), h3 = tr_read<v_rd_off(D0, 3, 1)>(vb);
    asm volatile("s_waitcnt lgkmcnt(0)" ::: "memory"); SBAR();
#define PK(L, H) (bf16x8){L[0], L[1], L[2], L[3], H[0], H[1], H[2], H[3]}
    od = __builtin_amdgcn_mfma_f32_32x32x16_bf16(pa0, PK(l0, h0), od, 0, 0, 0);
    od = __builtin_amdgcn_mfma_f32_32x32x16_bf16(pa1, PK(l1, h1), od, 0, 0, 0);
    od = __builtin_amdgcn_mfma_f32_32x32x16_bf16(pa2, PK(l2, h2), od, 0, 0, 0);
    od = __builtin_amdgcn_mfma_f32_32x32x16_bf16(pa3, PK(l3, h3), od, 0, 0, 0);
#undef PK
}
__device__ __forceinline__ void pv_d0(f32x16* o, int vb, bf16x8 pa0, bf16x8 pa1, bf16x8 pa2, bf16x8 pa3) {
    pv_one<0>(o[0], vb, pa0, pa1, pa2, pa3); pv_one<1>(o[1], vb, pa0, pa1, pa2, pa3); pv_one<2>(o[2], vb, pa0, pa1, pa2, pa3); pv_one<3>(o[3], vb, pa0, pa1, pa2, pa3);
}
__device__ __forceinline__ int t5_bucket(int rel) {
    const int n = rel < 0 ? -rel : rel; int b;
    if (n < 8) b = n; else if (n < 12) b = 8; else if (n < 16) b = 9; else if (n < 23) b = 10; else if (n < 32) b = 11; else if (n < 46) b = 12; else if (n < 64) b = 13; else if (n < 91) b = 14; else b = 15;
    return b + (rel > 0 ? 16 : 0);
}
constexpr int OFF_KR = 0, OFF_VR = 3 * 16384, OFF_WS2 = 6 * 16384, OFF_TBL2 = OFF_WS2 + 2048;
__device__ __forceinline__ void attn_unit(int b, int h, int qb, const bf16_t* __restrict__ P, bf16_t* __restrict__ mix, const float* __restrict__ relb, const float* __restrict__ subg, float lam, char* lds) {
    const int tid = threadIdx.x, wid = __builtin_amdgcn_readfirstlane(tid >> 6), lane = tid & 63, r32 = lane & 31, hi = lane >> 5, map = wid >> 2, wq = wid & 3;
    float* ws = (float*)(lds + OFF_WS2) + wid * 64; float* li_l = ws; float* al_l = ws + 32;
    float* tbl = (float*)(lds + OFF_TBL2);
    __syncthreads();
    for (int i = tid; i < 513; i += 512) tbl[i] = relb[t5_bucket(i - 256) * NH + h] * LOG2E;
    const float c_lo = relb[15 * NH + h] * LOG2E, c_hi = relb[31 * NH + h] * LOG2E;
    const int qpos0 = qb * 128 + wq * 32;
    const float* tblp = tbl + 256 - r32 + 4 * hi;
    float m_reg = -1e30f, l_reg = 0; f32x16 o[4] = {}; bf16x8 qr[4];
    const bf16_t* Qw = P + (size_t)(b * SEQ + qpos0 + r32) * LDP + Q_OFF + h * 128 + map * 64 + hi * 8;
#pragma unroll
    for (int d0 = 0; d0 < 4; ++d0) qr[d0] = *reinterpret_cast<const bf16x8*>(Qw + d0 * 16);
    const bf16_t* Kh = P + (size_t)(b * SEQ) * LDP + K_OFF + h * 128;
    const bf16_t* Vh = P + (size_t)(b * SEQ) * LDP + V_OFF + h * 128;
    unsigned kq[2], vq[2];
#pragma unroll
    for (int i = 0; i < 2; ++i) { const int ch = i * 512 + wid * 64 + lane;
        { const int row = ch >> 4, cpos = ch & 15; kq[i] = (unsigned)(row * LDP + ((cpos ^ (row & 7)) << 3)); }
        { const int sub = ch >> 5, wc = ch & 31, kk = (sub >> 2) * 8 + (wc >> 2), k = (kk & ~0xC) | ((kk & 4) << 1) | ((kk & 8) >> 1), c = (sub & 3) * 32 + (wc & 3) * 8; vq[i] = (unsigned)(k * LDP + c); } }
    LAS unsigned char* LL = (LAS unsigned char*)lds;
    const unsigned ldsw = (unsigned)wid * 1024u;
#define DMA_K(t, slot) do { _Pragma("unroll") for (int _i = 0; _i < 2; ++_i) __builtin_amdgcn_global_load_lds((const unsigned*)(Kh + (size_t)(t) * 64 * LDP + kq[_i]), (LAS unsigned*)(LL + OFF_KR + (slot) * 16384 + ldsw + _i * 8192), 16, 0, 0); } while (0)
#define DMA_V(t, slot) do { _Pragma("unroll") for (int _i = 0; _i < 2; ++_i) __builtin_amdgcn_global_load_lds((const unsigned*)(Vh + (size_t)(t) * 64 * LDP + vq[_i]), (LAS unsigned*)(LL + OFF_VR + (slot) * 16384 + ldsw + _i * 8192), 16, 0, 0); } while (0)
#define WAITBAR(N) asm volatile("s_waitcnt vmcnt(" #N ") lgkmcnt(0)\n\ts_barrier" ::: "memory")
#define RESC(a) do { if (__any((a) < 1.f)) { if (hi == 0) al_l[r32] = (a); asm volatile("s_waitcnt lgkmcnt(0)" ::: "memory"); \
    _Pragma("unroll") for (int d = 0; d < 4; ++d) _Pragma("unroll") for (int r = 0; r < 16; ++r) o[d][r] *= al_l[crow(r, hi)]; } } while (0)
    const int vb0 = (int)(uintptr_t)(lds + OFF_VR) + v_rd_base(lane);
    f32x16 pA0, pA1, pB0, pB1; float mnA, mnB, alA, alB; bf16x8 pa0, pa1, pa2, pa3; constexpr int NT = SEQ / 64;
    DMA_K(0, 0); DMA_K(1, 1); DMA_V(0, 0);
    WAITBAR(0);
    DMA_K(2, 2); DMA_V(1, 1);
    qkt(pA0, pA1, lds + OFF_KR, qr, r32, hi, map); partialSM(pA0, pA1, m_reg, mnA, alA, 0 - qpos0, c_lo, c_hi, tblp);
    int s0 = 1, s1 = 2, s2 = 0;
#pragma unroll 1
    for (int j = 1; j + 1 < NT; j += 2) {
        WAITBAR(4);
        DMA_K(j + 2, s2); DMA_V(j + 1, s1);
        SBAR(); qkt(pB0, pB1, lds + OFF_KR + s0 * 16384, qr, r32, hi, map);
        finishSM(pA0, pA1, alA, l_reg, pa0, pa1, pa2, pa3); SBAR();
        pv_d0(o, vb0 + s2 * 16384, pa0, pa1, pa2, pa3); partialSM(pB0, pB1, m_reg, mnB, alB, j * 64 - qpos0, c_lo, c_hi, tblp);
        RESC(alB);
        WAITBAR(4);
        if (j + 3 < NT) DMA_K(j + 3, s0);
        DMA_V(j + 2, s2);
        SBAR(); qkt(pA0, pA1, lds + OFF_KR + s1 * 16384, qr, r32, hi, map);
        finishSM(pB0, pB1, alB, l_reg, pa0, pa1, pa2, pa3); SBAR();
        pv_d0(o, vb0 + s0 * 16384, pa0, pa1, pa2, pa3); partialSM(pA0, pA1, m_reg, mnA, alA, (j + 1) * 64 - qpos0, c_lo, c_hi, tblp);
        RESC(alA);
        { const int t0 = s0; s0 = s2; s2 = s1; s1 = t0; }
    }
    WAITBAR(0);
    SBAR(); qkt(pB0, pB1, lds + OFF_KR + s0 * 16384, qr, r32, hi, map);
    finishSM(pA0, pA1, alA, l_reg, pa0, pa1, pa2, pa3); SBAR();
    pv_d0(o, vb0 + s2 * 16384, pa0, pa1, pa2, pa3); partialSM(pB0, pB1, m_reg, mnB, alB, (NT - 1) * 64 - qpos0, c_lo, c_hi, tblp);
    RESC(alB);
    finishSM(pB0, pB1, alB, l_reg, pa0, pa1, pa2, pa3); SBAR();
    pv_d0(o, vb0 + s0 * 16384, pa0, pa1, pa2, pa3);
    if (hi == 0) li_l[r32] = l_reg; asm volatile("s_waitcnt lgkmcnt(0)" ::: "memory");
    float rli[16];
#pragma unroll
    for (int r = 0; r < 16; ++r) rli[r] = __builtin_amdgcn_rcpf(li_l[crow(r, hi)]);
    __syncthreads();
    float* X = (float*)lds;
    if (map == 1) {
#pragma unroll
        for (int d0 = 0; d0 < 4; ++d0)
#pragma unroll
            for (int r = 0; r < 16; ++r) X[(d0 * 16 + r) * 256 + wq * 64 + lane] = o[d0][r] * rli[r];
    }
    __syncthreads();
    if (map == 0) {
        float sg[4];
#pragma unroll
        for (int d0 = 0; d0 < 4; ++d0) sg[d0] = subg[d0 * 32 + r32] * SUBLN_MUL;
        bf16_t* Ob = mix + (size_t)(b * SEQ + qpos0) * DM + h * 128 + r32;
#pragma unroll
        for (int r = 0; r < 16; ++r) {
            float v[4]; float ss = 0.f;
#pragma unroll
            for (int d0 = 0; d0 < 4; ++d0) { v[d0] = o[d0][r] * rli[r] - lam * X[(d0 * 16 + r) * 256 + wq * 64 + lane]; ss += v[d0] * v[d0]; }
#pragma unroll
            for (int s = 1; s < 32; s <<= 1) ss += __shfl_xor(ss, s);
            const float rms = __builtin_amdgcn_rsqf(ss * (1.0f / 128.0f) + LN_EPS);
            const int orow = crow(r, hi);
#pragma unroll
            for (int d0 = 0; d0 < 4; ++d0) Ob[(size_t)orow * DM + d0 * 32] = (bf16_t)(cvtpk(v[d0] * rms * sg[d0], 0.f) & 0xffffu);
        }
    }
#undef DMA_K
#undef DMA_V
#undef WAITBAR
#undef RESC
}

__device__ __forceinline__ void sg_unit(int b, int c, int g, const bf16_t* __restrict__ P, bf16_t* __restrict__ mix, const float* __restrict__ lng, const float* __restrict__ lnb,
                                        const bf16_t* __restrict__ sgw, const float* __restrict__ sgb, char* lds) {
    int tid = threadIdx.x; asm volatile("" : "+v"(tid));
    const int wid = tid >> 6, lane = tid & 63, r32 = lane & 31, hi = lane >> 5;
    const size_t row0 = (size_t)b * SEQ + (size_t)c * 128;
    const int sr = tid >> 4, sc = (tid & 15) * 8;
    __syncthreads();
    {
        const f32x4 g0 = *(const f32x4*)(lng + g * 128 + sc), g1 = *(const f32x4*)(lng + g * 128 + sc + 4), b0 = *(const f32x4*)(lnb + g * 128 + sc), b1 = *(const f32x4*)(lnb + g * 128 + sc + 4);
        u32x4 w[4];
#pragma unroll
        for (int i = 0; i < 4; ++i) w[i] = *reinterpret_cast<const u32x4*>(P + (row0 + sr + 32 * i) * LDP + G_OFF + g * 128 + sc);
#pragma unroll
        for (int i = 0; i < 4; ++i) {
            float v[8] = {bflo(w[i].x), bfhi(w[i].x), bflo(w[i].y), bfhi(w[i].y), bflo(w[i].z), bfhi(w[i].z), bflo(w[i].w), bfhi(w[i].w)};
            float s = ((v[0] + v[1]) + (v[2] + v[3])) + ((v[4] + v[5]) + (v[6] + v[7]));
            s += __shfl_xor(s, 1); s += __shfl_xor(s, 2); s += __shfl_xor(s, 4); s += __shfl_xor(s, 8);
            const float mean = s * (1.0f / 128.0f); float s2 = 0.f;
#pragma unroll
            for (int j = 0; j < 8; ++j) { v[j] -= mean; s2 += v[j] * v[j]; }
            s2 += __shfl_xor(s2, 1); s2 += __shfl_xor(s2, 2); s2 += __shfl_xor(s2, 4); s2 += __shfl_xor(s2, 8);
            const float rstd = __builtin_amdgcn_rsqf(s2 * (1.0f / 128.0f) + LN_EPS);
            u32x4 o; o.x = cvtpk(v[0] * rstd * g0[0] + b0[0], v[1] * rstd * g0[1] + b0[1]); o.y = cvtpk(v[2] * rstd * g0[2] + b0[2], v[3] * rstd * g0[3] + b0[3]);
            o.z = cvtpk(v[4] * rstd * g1[0] + b1[0], v[5] * rstd * g1[1] + b1[1]); o.w = cvtpk(v[6] * rstd * g1[2] + b1[2], v[7] * rstd * g1[3] + b1[3]);
            const int q = sr + 32 * i;
            *(u32x4*)(lds + (q >> 6) * 16384 + v_st(q & 63, sc)) = o;
        }
    }
    __syncthreads();
    const int pblk = wid >> 1, dbase = (wid & 1) * 2;
    f32x16 acc0 = {}, acc1 = {};
    const bf16_t* Wp = sgw + ((size_t)g * 128 + pblk * 32 + r32) * 128 + hi * 8;
    const int vb = (int)(uintptr_t)lds + v_rd_base(lane);
#define SGPK(L, H) (bf16x8){L[0], L[1], L[2], L[3], H[0], H[1], H[2], H[3]}
#define SG_STEP(T, KS) do { \
        const bf16x8 a_ = *reinterpret_cast<const bf16x8*>(Wp + ((T) * 4 + (KS)) * 16); \
        const s16x4 l0 = tr_read<(T) * 16384 + v_rd_off(0, KS, 0)>(vb + dbase * 512), h0 = tr_read<(T) * 16384 + v_rd_off(0, KS, 1)>(vb + dbase * 512); \
        const s16x4 l1 = tr_read<(T) * 16384 + v_rd_off(1, KS, 0)>(vb + dbase * 512), h1 = tr_read<(T) * 16384 + v_rd_off(1, KS, 1)>(vb + dbase * 512); \
        asm volatile("s_waitcnt lgkmcnt(0)" ::: "memory"); SBAR(); \
        acc0 = __builtin_amdgcn_mfma_f32_32x32x16_bf16(a_, SGPK(l0, h0), acc0, 0, 0, 0); \
        acc1 = __builtin_amdgcn_mfma_f32_32x32x16_bf16(a_, SGPK(l1, h1), acc1, 0, 0, 0); } while (0)
    SG_STEP(0, 0); SG_STEP(0, 1); SG_STEP(0, 2); SG_STEP(0, 3); SG_STEP(1, 0); SG_STEP(1, 1); SG_STEP(1, 2); SG_STEP(1, 3);
#undef SG_STEP
#undef SGPK
    float* M = (float*)(lds + 32768);
#pragma unroll
    for (int r = 0; r < 16; ++r) { const int p = pblk * 32 + crow(r, hi); const float bs = sgb[g * 128 + p];
        M[p * 132 + dbase * 32 + r32] = acc0[r] + bs; M[p * 132 + dbase * 32 + 32 + r32] = acc1[r] + bs; }
    __syncthreads();
#pragma unroll
    for (int i = 0; i < 4; ++i) { const int p = sr + 32 * i;
        const u32x4 uw = *reinterpret_cast<const u32x4*>(P + (row0 + p) * LDP + U_OFF + g * 128 + sc);
        const f32x4 m0 = *(const f32x4*)(M + p * 132 + sc), m1 = *(const f32x4*)(M + p * 132 + sc + 4);
        u32x4 o; o.x = cvtpk(bflo(uw.x) * m0[0], bfhi(uw.x) * m0[1]); o.y = cvtpk(bflo(uw.y) * m0[2], bfhi(uw.y) * m0[3]);
        o.z = cvtpk(bflo(uw.z) * m1[0], bfhi(uw.z) * m1[1]); o.w = cvtpk(bflo(uw.w) * m1[2], bfhi(uw.w) * m1[3]);
        *(u32x4*)(mix + (row0 + p) * DM + 1024 + g * 128 + sc) = o; }
}
#undef KSWZ
#undef SBAR
}

constexpr int NWAVES = 8;
constexpr int N_PHASES = 8;
struct Args { const float* in[24]; float* out; unsigned char* ws; int ph_lo, ph_hi; };
static_assert(sizeof(Args) == 24 * 8 + 8 + 8 + 8, "Args has no padding");

__global__ void __launch_bounds__(NWAVES * 64, 2) mega(Args args) {
    extern __shared__ __attribute__((aligned(16))) unsigned char lds[];
    LAS unsigned char* L = (LAS unsigned char*)lds;
    volatile LAS unsigned* MISC = (volatile LAS unsigned*)(L + MISC_OFF);
    const int tid = threadIdx.x, lane = tid & 63, wave = __builtin_amdgcn_readfirstlane(tid >> 6);
    const int G = gridDim.x; const int bx = blockIdx.x; const int vcu = (G % 8 == 0) ? (bx % 8) * (G / 8) + bx / 8 : bx;
    unsigned char* ws = args.ws;
    GAS unsigned* ctl = (GAS unsigned*)(ws + WS_CTL);
    const float* x = args.in[0]; const float* w_in = args.in[1]; const float* w_out = args.in[2];
    const float* ln1g = args.in[3]; const float* ln1b = args.in[4]; const float* ln2g = args.in[5]; const float* ln2b = args.in[6];
    const float* relb = args.in[7]; const float* lq1 = args.in[8]; const float* lk1 = args.in[9]; const float* lq2 = args.in[10]; const float* lk2 = args.in[11];
    const float* subg = args.in[12]; const float* sglng = args.in[13]; const float* sglnb = args.in[14]; const float* sgw = args.in[15]; const float* sgb = args.in[16];
    const float* wrg = args.in[17]; const float* brg = args.in[18]; const float* wre = args.in[19]; const float* bre = args.in[20];
    const float* wg = args.in[21]; const float* wu = args.in[22]; const float* wd = args.in[23];
    float* out = args.out;
    bf16_t* WinT = (bf16_t*)(ws + WS_WIN); bf16_t* WoutT = (bf16_t*)(ws + WS_WOUT); bf16_t* WguT = (bf16_t*)(ws + WS_WGU); bf16_t* WdT = (bf16_t*)(ws + WS_WD);
    bf16_t* sgwb = (bf16_t*)(ws + WS_SGW); bf16_t* xb = (bf16_t*)(ws + WS_XB); bf16_t* Pb = (bf16_t*)(ws + WS_P); bf16_t* mix = (bf16_t*)(ws + WS_MIX);
    float* Y = (float*)(ws + WS_Y); float* H1 = (float*)(ws + WS_H1); bf16_t* H1B = (bf16_t*)(ws + WS_H1B); bf16_t* HB = (bf16_t*)(ws + WS_HB); bf16_t* OB = (bf16_t*)(ws + WS_O);
    int* tokl = (int*)(ws + WS_TOKL); float* tokw = (float*)(ws + WS_TOKW);
    bf16_t* WRH = (bf16_t*)(ws + WS_WRH); bf16_t* WRL = (bf16_t*)(ws + WS_WRL);

    for (int u = tid; u < (LDS_BYTES - MISC_OFF) / 4; u += NWAVES * 64) ((LAS unsigned*)(L + MISC_OFF))[u] = 0u;
    __syncthreads();
    XcdBarrier bar; bar.bar = (unsigned*)(ws + WS_CTL) + CW_BAR; bar.x = 0; bar.st = nullptr;
    if (MK_N_LAUNCHES == 1) bar = xcd_barrier_post((unsigned*)(ws + WS_CTL) + CW_BAR, MISC + 8);
    const int lo = args.ph_lo, hi_ = args.ph_hi;
#ifndef PHASE_MASK
#define PHASE_MASK 0xff
#endif
#define IN(k) (((PHASE_MASK >> (k)) & 1) && lo <= (k) && (k) < hi_)
#define GRID_BAR(k) do { if (IN(k) && IN((k) + 1)) xcd_barrier(bar); } while (0)
    const int gw = vcu * NWAVES + wave, NGW = G * NWAVES;

    if (IN(0)) {
        LAS float* scr = (LAS float*)(L + wave * 16384);
        constexpr int I_IN = 32 * 160, I_OUT = 32 * 64;
        constexpr int NITEMS = I_IN + I_OUT;
        for (int it = gw; it < NITEMS; it += NGW) {
            int r = it;
            if (r < I_IN) { const int kb = r / 160, nb = r % 160; tr_item(w_in + (size_t)kb * 64 * INW + nb * 32, INW, WinT + (size_t)nb * 32 * DM + kb * 64, DM, scr, lane); continue; } r -= I_IN;
            { const int kb = r / 64, nb = r % 64; tr_item(w_out + (size_t)kb * 64 * DM + nb * 32, DM, WoutT + (size_t)nb * 32 * DM + kb * 64, DM, scr, lane); }
        }
        const size_t gt = (size_t)vcu * (NWAVES * 64) + tid, NGT = (size_t)G * NWAVES * 64;
        for (size_t i = gt; i < (size_t)TOK * DM / 8; i += NGT) { const f32x4 a = *(const f32x4*)(x + i * 8), b = *(const f32x4*)(x + i * 8 + 4);
            u32x4 w; w.x = cvt_pk_bf16(a[0], a[1]); w.y = cvt_pk_bf16(a[2], a[3]); w.z = cvt_pk_bf16(b[0], b[1]); w.w = cvt_pk_bf16(b[2], b[3]); *(u32x4*)(xb + i * 8) = w; }
        for (size_t i = gt; i < (size_t)48 * DM; i += NGT) { const int n = (int)(i / DM), k = (int)(i % DM);
            float w = 0.f; if (n < 4) w = wrg[(size_t)k * 4 + n]; else if (n < 36) { const int g2 = (n - 4) >> 3, i2 = (n - 4) & 7; w = wre[((size_t)g2 * DM + k) * EPG + i2]; }
            const unsigned hb = cvt_pk_bf16(w, 0.f) & 0xffffu; const float lo = w - __uint_as_float(hb << 16);
            WRH[i] = (bf16_t)hb; WRL[i] = (bf16_t)(cvt_pk_bf16(lo, 0.f) & 0xffffu); }
        for (size_t i = gt; i < (size_t)8 * 128 * 128 / 8; i += NGT) { const f32x4 a = *(const f32x4*)(sgw + i * 8), b = *(const f32x4*)(sgw + i * 8 + 4);
            u32x4 w; w.x = cvt_pk_bf16(a[0], a[1]); w.y = cvt_pk_bf16(a[2], a[3]); w.z = cvt_pk_bf16(b[0], b[1]); w.w = cvt_pk_bf16(b[2], b[3]); *(u32x4*)(sgwb + i * 8) = w; }
    }
    GRID_BAR(0);

    if (IN(1)) {
        pg8::SchedDense S; S.init(TOK, INW, DM, G, bx, xb, WinT);
        EpiProj E{Pb};
        pg8::gemm_phase<EpiProj, pg8::SchedDense, false>(L, DM, S, E, nullptr);
        constexpr int NU = (TOK / 256) * (INW / 256); const int rem = NU % G; const int nshort = G - rem;
        if (bx >= rem) {
            LAS float* scr = (LAS float*)(L + wave * 16384);
            constexpr int I_G = 32 * 256;
            for (int it = (bx - rem) * NWAVES + wave; it < 2 * I_G; it += nshort * NWAVES) {
                int r = it; const bool up = r >= I_G; if (up) r -= I_G; const int e = r / 256, q = r % 256, kb = q / 8, nb = q % 8;
                const float* src = (up ? wu : wg) + (size_t)e * DM * DEXP + (size_t)kb * 64 * DEXP + nb * 32;
                const int drow = e * 512 + (nb >> 2) * 256 + (up ? 128 : 0) + (nb & 3) * 32;
                tr_item(src, DEXP, WguT + (size_t)drow * DM + kb * 64, DM, scr, lane); }
        }
    }
    GRID_BAR(1);

    if (IN(2)) {
        float lam;
        { const float a = lane < 64 ? lq1[lane] * lk1[lane] : 0.f, c = lq2[lane] * lk2[lane];
          lam = __expf(wave_sum(a)) - __expf(wave_sum(c)) + LAM_INIT; }
        for (int u = vcu; u < 512; u += G) { const int bh = u >> 5, qb = u & 31; att::attn_unit(bh >> 3, bh & 7, qb, Pb, mix, relb, subg, lam, (char*)lds); }
        for (int u = vcu; u < 512; u += G) { const int g = u & 7, c = (u >> 3) & 31, b = u >> 8; att::sg_unit(b, c, g, Pb, mix, sglng, sglnb, sgwb, sgb, (char*)lds); }
        __syncthreads();
    }
    GRID_BAR(2);

    if (IN(3)) {
        pg8::SchedDense S; S.init(TOK, DM, DM, G, bx, mix, WoutT);
        EpiY E{x, Y};
        pg8::gemm_phase<EpiY, pg8::SchedDense, false>(L, DM, S, E, nullptr);
    }
    GRID_BAR(3);

    if (IN(4)) {
        constexpr int HSTR = 4112;
        LAS unsigned char* Hhi = L; LAS unsigned char* Hlo = L + 16 * HSTR;
        LAS float* part = (LAS float*)L;
        LAS float* lgt = (LAS float*)(L + 8 * 16 * 48 * 4);
        for (int t0 = vcu * 16; t0 < TOK; t0 += G * 16) {
            __syncthreads();
#pragma unroll
            for (int tt = 0; tt < 2; ++tt) {
                const int row = wave * 2 + tt, t = t0 + row;
                const f32x4* yr = (const f32x4*)(Y + (size_t)t * DM) + lane;
                f32x4 v[8]; float s = 0.f;
#pragma unroll
                for (int j = 0; j < 8; ++j) { v[j] = yr[64 * j]; s += (v[j][0] + v[j][1]) + (v[j][2] + v[j][3]); }
                const float mean = wave_sum(s) * (1.0f / DM); float s2 = 0.f;
#pragma unroll
                for (int j = 0; j < 8; ++j) { v[j] = v[j] - mean; s2 += (v[j][0] * v[j][0] + v[j][1] * v[j][1]) + (v[j][2] * v[j][2] + v[j][3] * v[j][3]); }
                const float rstd = 1.0f / sqrtf(wave_sum(s2) * (1.0f / DM) + LN_EPS);
#pragma unroll
                for (int j = 0; j < 8; ++j) { const int col = 256 * j + 4 * lane; const f32x4 gg = *(const f32x4*)(ln1g + col), bb = *(const f32x4*)(ln1b + col);
                    v[j] = v[j] * rstd * gg + bb;
                    u32x2 w; w.x = cvt_pk_bf16(v[j][0], v[j][1]); w.y = cvt_pk_bf16(v[j][2], v[j][3]); *(u32x2*)(H1B + (size_t)t * DM + col) = w;
                    u32x2 wl; wl.x = cvt_pk_bf16(v[j][0] - bflo(w.x), v[j][1] - bfhi(w.x)); wl.y = cvt_pk_bf16(v[j][2] - bflo(w.y), v[j][3] - bfhi(w.y));
                    *(LAS u32x2*)(Hhi + row * HSTR + col * 2) = w; *(LAS u32x2*)(Hlo + row * HSTR + col * 2) = wl; }
            }
            __syncthreads();
            f32x4 acc[3] = {{0.f, 0.f, 0.f, 0.f}, {0.f, 0.f, 0.f, 0.f}, {0.f, 0.f, 0.f, 0.f}};
            { const int ar = lane & 15, kc = lane >> 4;
#pragma unroll
              for (int sidx = 0; sidx < 8; ++sidx) { const int k = 256 * wave + 32 * sidx + 8 * kc;
                  const bf16x8 ah = *(const LAS bf16x8*)(Hhi + ar * HSTR + k * 2), al = *(const LAS bf16x8*)(Hlo + ar * HSTR + k * 2);
#pragma unroll
                  for (int nt = 0; nt < 3; ++nt) { const bf16x8 bh = *(const bf16x8*)(WRH + (size_t)(nt * 16 + ar) * DM + k), bl = *(const bf16x8*)(WRL + (size_t)(nt * 16 + ar) * DM + k);
                      acc[nt] = __builtin_amdgcn_mfma_f32_16x16x32_bf16(ah, bh, acc[nt], 0, 0, 0);
                      acc[nt] = __builtin_amdgcn_mfma_f32_16x16x32_bf16(al, bh, acc[nt], 0, 0, 0);
                      acc[nt] = __builtin_amdgcn_mfma_f32_16x16x32_bf16(ah, bl, acc[nt], 0, 0, 0); } } }
            __syncthreads();
#pragma unroll
            for (int nt = 0; nt < 3; ++nt)
#pragma unroll
                for (int r = 0; r < 4; ++r) part[(wave * 16 + (lane >> 4) * 4 + r) * 48 + nt * 16 + (lane & 15)] = acc[nt][r];
            __syncthreads();
            for (int i = tid; i < 16 * 48; i += NWAVES * 64) { float a = 0.f;
#pragma unroll
                for (int w = 0; w < 8; ++w) a += part[w * 768 + i];
                lgt[i] = a; }
            __syncthreads();
            if (tid < 16) {
                const int t = t0 + tid; const LAS float* lp = lgt + tid * 48;
                float lg[4];
#pragma unroll
                for (int q = 0; q < 4; ++q) lg[q] = lp[q] + brg[q];
                int gi = 0; float gm = lg[0];
#pragma unroll
                for (int q = 1; q < 4; ++q) if (lg[q] > gm) { gm = lg[q]; gi = q; }
                float gs = 0.f;
#pragma unroll
                for (int q = 0; q < 4; ++q) gs += __expf(lg[q] - gm);
                const float ggate = 1.0f / gs;
                float el[8];
#pragma unroll
                for (int q = 0; q < 8; ++q) el[q] = lp[4 + gi * 8 + q] + bre[gi * EPG + q];
                int i1 = 0; float v1 = el[0];
#pragma unroll
                for (int q = 1; q < 8; ++q) if (el[q] > v1) { v1 = el[q]; i1 = q; }
                int i2 = -1; float v2 = -3.0e38f;
#pragma unroll
                for (int q = 0; q < 8; ++q) if (q != i1 && el[q] > v2) { v2 = el[q]; i2 = q; }
                const float e2 = __expf(v2 - v1); const float w1 = ggate / (1.0f + e2), w2 = ggate * e2 / (1.0f + e2);
                const int ex1 = gi * EPG + i1, ex2 = gi * EPG + i2;
                const unsigned p1 = __hip_atomic_fetch_add(ctl + CW_CNT + 64 * ex1, 1u, RLX_AGENT);
                const unsigned p2 = __hip_atomic_fetch_add(ctl + CW_CNT + 64 * ex2, 1u, RLX_AGENT);
                tokl[ex1 * TOK + p1] = t; tokw[ex1 * TOK + p1] = w1;
                tokl[ex2 * TOK + p2] = t | (1 << 16); tokw[ex2 * TOK + p2] = w2;
            }
        }
        __syncthreads();
    }
    GRID_BAR(4);

    LAS int* tab = (LAS int*)(L + LDSX_OFF);
    if (IN(5) || IN(6)) {
        __syncthreads();
        if (tid < 32) {
            const int c = (int)__hip_atomic_load(ctl + CW_CNT + 64 * tid, RLX_AGENT); const int n = (c + 255) >> 8;
            int incl = n;
#pragma unroll
            for (int o = 1; o < 32; o <<= 1) { const int v = __shfl_up(incl, o); if (tid >= o) incl += v; }
            int t = incl - n;
            for (int l = 0; l < n; ++l, ++t) { tab[1 + 4 * t] = tid; tab[2 + 4 * t] = l; tab[3 + 4 * t] = (c - l * 256) < 256 ? (c - l * 256) : 256; tab[4 + 4 * t] = 0; }
            if (tid == 31) tab[0] = incl;
        }
        __syncthreads();
    }
    if (IN(5)) {
        SchedMoE S{tab, 2, G, bx, (const char*)H1B, (const char*)WguT, (size_t)256 * DM * 2, true};
        EpiGU E{HB, tokw};
        pg8::gemm_phase<EpiGU, SchedMoE, true>(L, DM, S, E, tokl);
        { const int NTt = __builtin_amdgcn_readfirstlane(tab[0]); const int nbusy = 2 * NTt < G ? 2 * NTt : 0; const int nidle = G - nbusy;
          if (bx >= nbusy) {
              LAS float* scr = (LAS float*)(L + wave * 16384);
              for (int r = (bx - nbusy) * NWAVES + wave; r < 32 * 256; r += nidle * NWAVES) { const int e = r / 256, q = r % 256, kb = q / 64, nb = q % 64;
                  tr_item(wd + (size_t)e * DEXP * DM + (size_t)kb * 64 * DM + nb * 32, DM, WdT + ((size_t)e * DM + nb * 32) * DEXP + kb * 64, DEXP, scr, lane); } } }
    }
    GRID_BAR(5);
    if (IN(6)) {
        SchedMoE S{tab, 8, G, bx, (const char*)HB, (const char*)WdT, (size_t)256 * DEXP * 2, false};
        EpiDown E{OB, tokl};
        pg8::gemm_phase<EpiDown, SchedMoE, false>(L, DEXP, S, E, nullptr);
    }
    GRID_BAR(6);

    if (IN(7)) {
        for (int t = gw; t < TOK; t += NGW) {
            f32x4 v[8]; float s = 0.f;
#pragma unroll
            for (int j = 0; j < 8; ++j) { const int col = 256 * j + 4 * lane; const u32x2 hb = *(const u32x2*)(H1B + (size_t)t * DM + col); const f32x4 h = {bflo(hb.x), bfhi(hb.x), bflo(hb.y), bfhi(hb.y)};
                const u32x2 a = *(const u32x2*)(OB + (size_t)t * DM + col), b = *(const u32x2*)(OB + ((size_t)TOK + t) * DM + col);
                v[j][0] = h[0] * DN_ALPHA + (bflo(a.x) + bflo(b.x)); v[j][1] = h[1] * DN_ALPHA + (bfhi(a.x) + bfhi(b.x));
                v[j][2] = h[2] * DN_ALPHA + (bflo(a.y) + bflo(b.y)); v[j][3] = h[3] * DN_ALPHA + (bfhi(a.y) + bfhi(b.y));
                s += (v[j][0] + v[j][1]) + (v[j][2] + v[j][3]); }
            const float mean = wave_sum(s) * (1.0f / DM); float s2 = 0.f;
#pragma unroll
            for (int j = 0; j < 8; ++j) { v[j] = v[j] - mean; s2 += (v[j][0] * v[j][0] + v[j][1] * v[j][1]) + (v[j][2] * v[j][2] + v[j][3] * v[j][3]); }
            const float rstd = 1.0f / sqrtf(wave_sum(s2) * (1.0f / DM) + LN_EPS);
#pragma unroll
            for (int j = 0; j < 8; ++j) { const int col = 256 * j + 4 * lane; const f32x4 gg = *(const f32x4*)(ln2g + col), bb = *(const f32x4*)(ln2b + col);
                *(f32x4*)(out + (size_t)t * DM + col) = v[j] * rstd * gg + bb; }
        }
    }
#undef IN
#undef GRID_BAR
}

extern "C" void kernel_launch(void* const* d_in, const int* in_sizes, int n_in, void* d_out, int out_size, void* d_ws, size_t ws_size, hipStream_t stream) {
    static int grid = 0;
    if (grid == 0) {
        if (n_in != 24 || out_size != TOK * DM || ws_size < WS_END) { fprintf(stderr, "kernel_launch: unexpected shapes (n_in %d out %d ws %zu)\n", n_in, out_size, ws_size); grid = -1; return; }
        int dev = 0, cus = 0, per_cu = 0;
        if (hipGetDevice(&dev) != hipSuccess || hipDeviceGetAttribute(&cus, hipDeviceAttributeMultiprocessorCount, dev) != hipSuccess) { grid = -1; return; }
        if (hipFuncSetAttribute((const void*)mega, hipFuncAttributeMaxDynamicSharedMemorySize, LDS_BYTES) != hipSuccess) { fprintf(stderr, "kernel_launch: hipFuncSetAttribute failed\n"); grid = -1; return; }
        if (hipOccupancyMaxActiveBlocksPerMultiprocessor(&per_cu, (const void*)mega, NWAVES * 64, LDS_BYTES) != hipSuccess || per_cu < 1)
            fprintf(stderr, "kernel_launch: occupancy query reports %d workgroups per CU\n", per_cu);
        (void)hipGetLastError();
        grid = cus;
    }
    if (grid < 0) return;
    if (hipMemsetAsync((char*)d_ws + WS_CTL, 0, CTL_ZERO_BYTES, stream) != hipSuccess) return;
    Args a{};
    for (int i = 0; i < 24; ++i) a.in[i] = (const float*)d_in[i];
    a.out = (float*)d_out; a.ws = (unsigned char*)d_ws;
    if (MK_N_LAUNCHES == 1) { a.ph_lo = 0; a.ph_hi = N_PHASES; hipLaunchKernelGGL(mega, dim3(grid), dim3(NWAVES * 64), LDS_BYTES, stream, a); }
    else {
#ifndef PROBE_REP
#define PROBE_REP 1,1,1,1,1,1,1,1
#endif
        const int reps[N_PHASES] = {PROBE_REP};
        for (int p = 0; p < N_PHASES; ++p) for (int r = 0; r < reps[p]; ++r) {
            if (p == 4 && r > 0) (void)hipMemsetAsync((char*)d_ws + WS_CTL, 0, CTL_ZERO_BYTES, stream);
            a.ph_lo = p; a.ph_hi = p + 1; hipLaunchKernelGGL(mega, dim3(grid), dim3(NWAVES * 64), LDS_BYTES, stream, a); }
    }
}
```
